# Optimizing an MI355X kernel written in HIP

```python
import math
import jax
import jax.numpy as jnp
from jax import lax
import numpy as np

D_MODEL = 1024
BATCH = 16
SEQ = 2048
DEPTH = 4

MEM_LEN = 256
HG_HEADS = 4
HG_DK = 128
HG_DV = 128
HG_WIDTH = HG_HEADS * HG_DV
GD_HEADS = 4
GD_DK = 128
GD_DV = 128
GD_WIDTH = GD_HEADS * GD_DV
MIX_WIDTH = HG_WIDTH + GD_WIDTH
CONV_K = 4
GD_CONV_WIDTH = 2 * GD_HEADS * GD_DK + GD_WIDTH
CHUNK = 64
IN_SPLITS = (HG_HEADS * HG_DK, HG_HEADS * HG_DK, HG_WIDTH, HG_WIDTH,
             GD_HEADS * GD_DK, GD_HEADS * GD_DK, GD_WIDTH, GD_HEADS, GD_HEADS, GD_WIDTH)
IN_WIDTH = sum(IN_SPLITS)
MEM_HEADS = 4
MEM_DH = D_MODEL // MEM_HEADS
N_GROUPS = 4
EXPERTS_PER_GROUP = 8
N_EXPERTS = N_GROUPS * EXPERTS_PER_GROUP
TOP_K = 2
D_EXPERT = 512
EXPERT_BLOCK = 128
ALPHA = (2.0 * DEPTH) ** 0.25
BETA = (8.0 * DEPTH) ** -0.25
LN_EPS = 1e-5
RMS_EPS = 1e-6
L2_EPS = 1e-6

kernel_name = 'hybrid_hgrn2_gdn_hmoe_trunk'


def layer_norm(x, g, b):
    xf = x.astype(jnp.float32)
    mu = jnp.mean(xf, axis=-1, keepdims=True)
    var = jnp.mean(jnp.square(xf - mu), axis=-1, keepdims=True)
    return ((xf - mu) * lax.rsqrt(var + LN_EPS) * g + b).astype(x.dtype)


def gated_rms_norm(o, w, gate):
    o = o * lax.rsqrt(jnp.mean(o * o, axis=-1, keepdims=True) + RMS_EPS) * w.astype(jnp.float32)
    return o * gate


def l2_normalize(x):
    return x * lax.rsqrt(jnp.sum(x * x, axis=-1, keepdims=True) + L2_EPS)


def causal_depthwise_conv_silu(x, w):
    y = lax.conv_general_dilated(
        x, w[:, None, :], window_strides=(1,), padding=[(CONV_K - 1, 0)],
        dimension_numbers=('NWC', 'WIO', 'NWC'), feature_group_count=x.shape[-1])
    return jax.nn.silu(y)


def to_chunks(x):
    b, t, h, d = x.shape
    return x.reshape(b, t // CHUNK, CHUNK, h, d).transpose(1, 0, 3, 2, 4)


def from_chunks(x):
    n, b, h, c, d = x.shape
    return x.transpose(1, 0, 3, 2, 4).reshape(b, n * c, h, d)


def hgrn2_chunked(q, k, v, log_f):
    qc, kc, vc, gc = to_chunks(q), to_chunks(k), to_chunks(v), to_chunks(log_f)
    causal = jnp.tril(jnp.ones((CHUNK, CHUNK), dtype=bool))
    bsz, h = q.shape[0], q.shape[2]

    def step(S, inp):
        qi, ki, vi, gi = inp
        cum = jnp.cumsum(gi, axis=2)
        diff = cum[:, :, :, None, :] - cum[:, :, None, :, :]
        decay = jnp.exp(jnp.where(causal[:, :, None], diff, -jnp.inf))
        scores = jnp.einsum('bhtd,bhsd,bhtsd->bhts', qi, ki, decay)
        o = (jnp.einsum('bhtd,bhdv->bhtv', qi * jnp.exp(cum), S)
             + jnp.einsum('bhts,bhsv->bhtv', scores, vi))
        cum_last = cum[:, :, -1, :]
        S = (jnp.exp(cum_last)[..., None] * S
             + jnp.einsum('bhsd,bhsv->bhdv', ki * jnp.exp(cum_last[:, :, None, :] - cum), vi))
        return S, o

    S0 = jnp.zeros((bsz, h, q.shape[-1], v.shape[-1]), jnp.float32)
    _, o = lax.scan(step, S0, (qc, kc, vc, gc))
    return from_chunks(o)


def gated_delta_chunked(q, k, v, g, beta):
    qc, kc, vc = to_chunks(q), to_chunks(k), to_chunks(v)
    gc = to_chunks(g[..., None])[..., 0]
    bc = to_chunks(beta[..., None])[..., 0]
    cum = jnp.cumsum(gc, axis=-1)
    diff = cum[..., :, None] - cum[..., None, :]
    incl = jnp.tril(jnp.ones((CHUNK, CHUNK), dtype=bool))
    strict = jnp.tril(jnp.ones((CHUNK, CHUNK), dtype=bool), -1)
    decay = jnp.exp(jnp.where(incl, diff, -jnp.inf))
    kb = kc * bc[..., None]
    a_mat = jnp.where(strict, jnp.einsum('nbhtd,nbhsd->nbhts', kb, kc) * decay, 0.0)
    u = lax.linalg.triangular_solve(a_mat, vc * bc[..., None], left_side=True, lower=True,
                                    unit_diagonal=True)
    w = lax.linalg.triangular_solve(a_mat, kb * jnp.exp(cum)[..., None], left_side=True,
                                    lower=True, unit_diagonal=True)
    qk = jnp.einsum('nbhtd,nbhsd->nbhts', qc, kc) * decay
    bsz, h = q.shape[0], q.shape[2]

    def step(S, inp):
        qi, ki, ui, wi, ci, qki = inp
        v_new = ui - jnp.einsum('bhtd,bhdv->bhtv', wi, S)
        o = (jnp.einsum('bhtd,bhdv->bhtv', qi * jnp.exp(ci)[..., None], S)
             + jnp.einsum('bhts,bhsv->bhtv', qki, v_new))
        c_last = ci[..., -1:]
        S = (jnp.exp(c_last)[..., None] * S
             + jnp.einsum('bhsd,bhsv->bhdv', ki * jnp.exp(c_last - ci)[..., None], v_new))
        return S, o

    S0 = jnp.zeros((bsz, h, q.shape[-1], v.shape[-1]), jnp.float32)
    _, o = lax.scan(step, S0, (qc, kc, u, w, cum, qk))
    return from_chunks(o)


def hybrid_mixer(x, w_in, w_out, hg_lb, hg_norm_w, gd_conv_w, gd_a_log, gd_dt_bias, gd_norm_w):
    b, t, _ = x.shape
    proj = (x @ w_in).astype(jnp.float32)
    offs = np.cumsum(IN_SPLITS)[:-1].tolist()
    hq, hf, hi, hz, gq, gk, gv, ga, gb, gz = jnp.split(proj, offs, axis=-1)

    lb = hg_lb.astype(jnp.float32).reshape(HG_HEADS, HG_DK)
    zf = hf.reshape(b, t, HG_HEADS, HG_DK)
    log_f = jnp.logaddexp(jnp.log(lb), jnp.log1p(-lb) + jax.nn.log_sigmoid(zf))
    k_hg = (1.0 - lb) * jax.nn.sigmoid(-zf)
    o_hg = hgrn2_chunked(hq.reshape(b, t, HG_HEADS, HG_DK), k_hg,
                         hi.reshape(b, t, HG_HEADS, HG_DV), log_f)
    y_hg = gated_rms_norm(o_hg, hg_norm_w, jax.nn.sigmoid(hz.reshape(b, t, HG_HEADS, HG_DV)))

    qkv = causal_depthwise_conv_silu(jnp.concatenate([gq, gk, gv], axis=-1),
                                     gd_conv_w.astype(jnp.float32))
    cq, ck, cv = jnp.split(qkv, [GD_HEADS * GD_DK, 2 * GD_HEADS * GD_DK], axis=-1)
    q_gd = l2_normalize(cq.reshape(b, t, GD_HEADS, GD_DK)) * (GD_DK ** -0.5)
    k_gd = l2_normalize(ck.reshape(b, t, GD_HEADS, GD_DK))
    v_gd = cv.reshape(b, t, GD_HEADS, GD_DV)
    g_gd = -jnp.exp(gd_a_log.astype(jnp.float32)) * jax.nn.softplus(ga + gd_dt_bias.astype(jnp.float32))
    beta = jax.nn.sigmoid(gb)
    o_gd = gated_delta_chunked(q_gd, k_gd, v_gd, g_gd, beta)
    y_gd = gated_rms_norm(o_gd, gd_norm_w, jax.nn.silu(gz.reshape(b, t, GD_HEADS, GD_DV)))

    y = jnp.concatenate([y_hg.reshape(b, t, HG_WIDTH), y_gd.reshape(b, t, GD_WIDTH)], axis=-1)
    return y.astype(x.dtype) @ w_out


def memory_cross_attention(x, mem_n, wq, wk, wv, wo):
    b, t, _ = x.shape
    m = mem_n.shape[1]
    q = (x @ wq).reshape(b, t, MEM_HEADS, MEM_DH)
    k = (mem_n @ wk).reshape(b, m, MEM_HEADS, MEM_DH)
    v = (mem_n @ wv).reshape(b, m, MEM_HEADS, MEM_DH)
    s = jnp.einsum('bthd,bmhd->bhtm', q, k).astype(jnp.float32) * (MEM_DH ** -0.5)
    p = jax.nn.softmax(s, axis=-1).astype(v.dtype)
    o = jnp.einsum('bhtm,bmhd->bthd', p, v).reshape(b, t, D_MODEL)
    return o @ wo


def hierarchical_moe(x, w_group, b_group, w_router, b_router, w_gate, w_up, w_down):
    b, t, d = x.shape
    n_tok = b * t
    xt = x.reshape(n_tok, d)
    tok = jnp.arange(n_tok)
    group_logits = (xt @ w_group).astype(jnp.float32) + b_group.astype(jnp.float32)
    group_p = jax.nn.softmax(group_logits, axis=-1)
    g_sel = jnp.argmax(group_logits, axis=-1)
    g_gate = group_p[tok, g_sel]
    exp_logits = ((xt @ w_router).astype(jnp.float32) + b_router.astype(jnp.float32)
                  ).reshape(n_tok, N_GROUPS, EXPERTS_PER_GROUP)
    local_logits = exp_logits[tok, g_sel]
    top_logits, top_local = lax.top_k(local_logits, TOP_K)
    gate = jax.nn.softmax(top_logits, axis=-1) * g_gate[:, None]
    expert_id = g_sel[:, None] * EXPERTS_PER_GROUP + top_local

    m = n_tok * TOP_K
    flat_e = expert_id.reshape(m)
    flat_tok = jnp.arange(m) // TOP_K
    flat_w = gate.reshape(m)
    order = jnp.argsort(flat_e)
    se, stok, sw = flat_e[order], flat_tok[order], flat_w[order]
    counts = jnp.zeros((N_EXPERTS,), jnp.int32).at[flat_e].add(1)
    starts = jnp.cumsum(counts) - counts
    pcounts = (counts + EXPERT_BLOCK - 1) // EXPERT_BLOCK * EXPERT_BLOCK
    pends = jnp.cumsum(pcounts)
    pstarts = pends - pcounts
    dest = pstarts[se] + jnp.arange(m) - starts[se]
    n_blocks = -(-m // EXPERT_BLOCK) + N_EXPERTS
    buf = jnp.zeros((n_blocks * EXPERT_BLOCK, d), x.dtype).at[dest].set(xt[stok])
    block_expert = jnp.minimum(
        jnp.searchsorted(pends, jnp.arange(n_blocks) * EXPERT_BLOCK, side='right'), N_EXPERTS - 1)

    def expert_block(args):
        xb, e = args
        h = jax.nn.silu(xb @ w_gate[e]) * (xb @ w_up[e])
        return h @ w_down[e]

    ybuf = lax.map(expert_block, (buf.reshape(n_blocks, EXPERT_BLOCK, d), block_expert))
    y = ybuf.reshape(n_blocks * EXPERT_BLOCK, d)[dest] * sw[:, None].astype(x.dtype)
    out = jnp.zeros((n_tok, d), x.dtype).at[stok].add(y)
    return out.reshape(b, t, d)


def setup_inputs(seed: int = 0) -> dict:
    key = jax.random.key(seed)
    ks = jax.random.split(key, 28)
    f32 = jnp.float32
    D = D_MODEL

    def nrm(k, shape, scale):
        return jax.random.normal(k, shape, f32) * scale

    x = nrm(ks[0], (BATCH, SEQ, D), 1.0)
    mem = nrm(ks[1], (BATCH, MEM_LEN, D), 1.0)
    w_in = nrm(ks[2], (DEPTH, D, IN_WIDTH), D ** -0.5)
    hg_lb_logits = nrm(ks[3], (DEPTH, HG_HEADS * HG_DK), 0.5)
    hg_norm_w = 1.0 + nrm(ks[4], (DEPTH, HG_DV), 0.02)
    gd_conv_w = nrm(ks[5], (DEPTH, CONV_K, GD_CONV_WIDTH), CONV_K ** -0.5)
    gd_a_log = jnp.log(jax.random.uniform(ks[6], (DEPTH, GD_HEADS), f32, 1.0, 16.0))
    dt = jnp.exp(jax.random.uniform(ks[7], (DEPTH, GD_HEADS), f32, math.log(1e-3), math.log(1e-1)))
    gd_dt_bias = dt + jnp.log(-jnp.expm1(-dt))
    gd_norm_w = 1.0 + nrm(ks[8], (DEPTH, GD_DV), 0.02)
    w_out = nrm(ks[9], (DEPTH, MIX_WIDTH, D), MIX_WIDTH ** -0.5 * BETA)
    mem_ln_g = 1.0 + nrm(ks[10], (D,), 0.02)
    mem_ln_b = nrm(ks[11], (D,), 0.02)
    w_mq = nrm(ks[12], (DEPTH, D, D), D ** -0.5)
    w_mk = nrm(ks[13], (DEPTH, D, D), D ** -0.5)
    w_mv = nrm(ks[14], (DEPTH, D, D), D ** -0.5)
    w_mo = nrm(ks[15], (DEPTH, D, D), D ** -0.5 * BETA)
    w_group = nrm(ks[16], (DEPTH, D, N_GROUPS), D ** -0.5)
    b_group = nrm(ks[17], (DEPTH, N_GROUPS), 0.01)
    w_router = nrm(ks[18], (DEPTH, D, N_EXPERTS), D ** -0.5)
    b_router = nrm(ks[19], (DEPTH, N_EXPERTS), 0.01)
    w_gate = nrm(ks[20], (DEPTH, N_EXPERTS, D, D_EXPERT), D ** -0.5)
    w_up = nrm(ks[21], (DEPTH, N_EXPERTS, D, D_EXPERT), D ** -0.5)
    w_down = nrm(ks[22], (DEPTH, N_EXPERTS, D_EXPERT, D), D_EXPERT ** -0.5 * BETA)
    ln_g = 1.0 + nrm(ks[23], (DEPTH, 3, D), 0.02)
    ln_b = nrm(ks[24], (DEPTH, 3, D), 0.02)
    return {'x': x, 'mem': mem, 'w_in': w_in, 'hg_lb_logits': hg_lb_logits,
            'hg_norm_w': hg_norm_w, 'gd_conv_w': gd_conv_w, 'gd_a_log': gd_a_log,
            'gd_dt_bias': gd_dt_bias, 'gd_norm_w': gd_norm_w, 'w_out': w_out,
            'mem_ln_g': mem_ln_g, 'mem_ln_b': mem_ln_b, 'w_mq': w_mq, 'w_mk': w_mk,
            'w_mv': w_mv, 'w_mo': w_mo, 'w_group': w_group, 'b_group': b_group,
            'w_router': w_router, 'b_router': b_router, 'w_gate': w_gate, 'w_up': w_up,
            'w_down': w_down, 'ln_g': ln_g, 'ln_b': ln_b}


def reference(x, mem, w_in, hg_lb_logits, hg_norm_w, gd_conv_w, gd_a_log, gd_dt_bias,
              gd_norm_w, w_out, mem_ln_g, mem_ln_b, w_mq, w_mk, w_mv, w_mo, w_group, b_group,
              w_router, b_router, w_gate, w_up, w_down, ln_g, ln_b):
    p_lb = jax.nn.softmax(hg_lb_logits.astype(jnp.float32), axis=0)
    lb_all = jnp.cumsum(p_lb, axis=0)
    lb_all = lb_all - lb_all[0]
    mem_n = layer_norm(mem, mem_ln_g, mem_ln_b)
    for l in range(DEPTH):
        mix = hybrid_mixer(x, w_in[l], w_out[l], lb_all[l], hg_norm_w[l], gd_conv_w[l],
                           gd_a_log[l], gd_dt_bias[l], gd_norm_w[l])
        x = layer_norm(ALPHA * x + mix, ln_g[l, 0], ln_b[l, 0])
        xa = memory_cross_attention(x, mem_n, w_mq[l], w_mk[l], w_mv[l], w_mo[l])
        x = layer_norm(ALPHA * x + xa, ln_g[l, 1], ln_b[l, 1])
        ff = hierarchical_moe(x, w_group[l], b_group[l], w_router[l], b_router[l],
                              w_gate[l], w_up[l], w_down[l])
        x = layer_norm(ALPHA * x + ff, ln_g[l, 2], ln_b[l, 2])
    return x
```

```cpp
#include <hip/hip_runtime.h>
#include <cstdio>
#include <cstdint>

#ifndef MK_ONE_LAUNCH
#define MK_ONE_LAUNCH 0
#endif

#define LAS __attribute__((address_space(3)))
#define GAS __attribute__((address_space(1)))
typedef unsigned short bf16;
typedef short bf16x8 __attribute__((ext_vector_type(8)));
typedef float f32x4 __attribute__((ext_vector_type(4)));
typedef float f32x2 __attribute__((ext_vector_type(2)));
typedef unsigned u32x4 __attribute__((ext_vector_type(4)));
typedef unsigned u32x2 __attribute__((ext_vector_type(2)));

constexpr int D = 1024, NB = 16, T = 2048, DEPTH = 4, NTOK = NB * T;
constexpr int MEM = 256, NMEM = NB * MEM;
constexpr int INW = 4104, PW = 4096;
constexpr int NEXP = 32, DEXP = 512;
constexpr int MAXROWS = 74240, MAXTILES = MAXROWS / 256;
constexpr float ALPHA = 1.681792830507429f;
constexpr float LN_EPS = 1e-5f, RMS_EPS = 1e-6f, L2_EPS = 1e-6f;

constexpr size_t MiB = 1u << 20;
constexpr size_t WS_CTL = 0, CTL_ZERO_BYTES = 1 * MiB;
constexpr size_t WS_SMALL = 1 * MiB;
constexpr size_t SM_LB = 0, SM_WAB = 16384, SM_CNT = 262144, SM_TILE = 327680;
constexpr size_t WS_W_IN = 2 * MiB;
constexpr size_t WS_W_OUT = 34 * MiB;
constexpr size_t WS_W_Q = 42 * MiB, WS_W_O = 50 * MiB, WS_W_K = 58 * MiB, WS_W_V = 66 * MiB;
constexpr size_t WS_KMEM = 74 * MiB, WS_VT = 106 * MiB;
constexpr size_t WS_MEMN = 138 * MiB;
constexpr size_t WS_X = 146 * MiB;
constexpr size_t WS_XN = 274 * MiB;
constexpr size_t WS_Y = 338 * MiB;
constexpr size_t WS_F = 402 * MiB;
constexpr size_t WS_PROJ = 466 * MiB;
constexpr size_t WS_Q = WS_PROJ, WS_P = WS_PROJ + 64 * MiB;
constexpr size_t WS_BUF = WS_PROJ, WS_H = WS_PROJ + 146 * MiB;
constexpr size_t WS_GU = 722 * MiB;
constexpr size_t WS_DN = 786 * MiB;
constexpr size_t WS_QC = 818 * MiB, WS_KC = 850 * MiB, WS_VC = 882 * MiB;
constexpr size_t WS_G = 914 * MiB;
constexpr size_t G_BETA = 512 * 1024, G_ROUTE = 1 * MiB, G_GATES = 1536 * 1024, G_DEST = 1792 * 1024;
constexpr size_t WS_END = 916 * MiB;

constexpr int RING_BYTES = 131072;
constexpr int EPI_OFF = RING_BYTES;
constexpr int MISC_OFF = RING_BYTES + 8192;
constexpr int LDS_BYTES = 147456;

#define LDS_WAIT() asm volatile("s_waitcnt lgkmcnt(0)" ::: "memory")
#define VM_WAIT() asm volatile("s_waitcnt vmcnt(0)" ::: "memory")
__device__ __forceinline__ unsigned f2bf(float f) { unsigned u = __builtin_bit_cast(unsigned, f); return (u + 0x7fffu + ((u >> 16) & 1u)) >> 16; }
__device__ __forceinline__ unsigned pk2(float lo, float hi) { return f2bf(lo) | (f2bf(hi) << 16); }
__device__ __forceinline__ float bf2f(unsigned b) { return __builtin_bit_cast(float, b << 16); }
__device__ __forceinline__ float bflo(unsigned w) { return __builtin_bit_cast(float, w << 16); }
__device__ __forceinline__ float bfhi(unsigned w) { return __builtin_bit_cast(float, w & 0xffff0000u); }
__device__ __forceinline__ float shx(float v, int o, int lane) { return __builtin_bit_cast(float, __builtin_amdgcn_ds_bpermute((lane ^ o) << 2, __builtin_bit_cast(int, v))); }
__device__ __forceinline__ float wave_sum(float v, int lane) {
#pragma unroll
    for (int o = 1; o < 64; o <<= 1) v += shx(v, o, lane);
    return v;
}
__device__ __forceinline__ int fresh_lane() { int l; asm volatile("v_mbcnt_lo_u32_b32 %0, -1, 0\n\tv_mbcnt_hi_u32_b32 %0, -1, %0" : "=v"(l)); return l; }
__device__ __forceinline__ float sigmoidf_(float z) { return 1.0f / (1.0f + __expf(-z)); }

namespace pg8 {
constexpr int BM = 256, BK = 64, HALF = 128, HTB = HALF * BK * 2, STAGE_BYTES = 8 * HTB;
__host__ __device__ __forceinline__ int lds_byte(int r, int c) { const int st = (r >> 4) * 2 + (c >> 5), rr = r & 15, cc = c & 31, ob = rr * 64 + cc * 2; return st * 1024 + (ob ^ (((ob >> 9) & 1) << 5)); }
__host__ __device__ __forceinline__ void stage_rc(int b, int& R, int& C) { const int st = b / 1024, sb = b % 1024, swz = sb ^ (((sb >> 9) & 1) << 5); R = (st >> 1) * 16 + swz / 64; C = (st & 1) * 32 + (swz % 64) / 2; }
__host__ __device__ __forceinline__ int perm32(int rho) { const int n = rho >> 4, i = rho & 15; return 8 * (i >> 2) + 4 * n + (i & 3); }

struct Unit { const char* A; const char* B; int pm, pn, aux; };
struct Shape { int K, lda, ldb; };

__device__ __forceinline__ void tile_of(int L, int nM, int nN, int& pm, int& pn) {
    const int nwg = nM * nN; int wgid = L;
    { const int q = nwg / 8, r = nwg % 8, xcd = wgid % 8, off = wgid / 8; wgid = (xcd < r ? xcd * (q + 1) : r * (q + 1) + (xcd - r) * q) + off; }
    const int nig = 8 * nN, gid = wgid / nig, fm = gid * 8, gsz = (nM - fm) < 8 ? (nM - fm) : 8;
    pm = fm + ((wgid % nig) % gsz); pn = (wgid % nig) / gsz;
}

template <class Epi, class Sched>
__device__ __forceinline__ void gemm_phase(LAS unsigned char* lds, const Shape g, const Sched& S, const Epi& E, const int tid) {
    const int wid = __builtin_amdgcn_readfirstlane(tid >> 6), lane = tid & 63, wr = wid >> 2, wc = wid & 3, fr = lane & 15, fq = lane >> 4;
    const int K = g.K, nt = K / BK;
    unsigned voffA[2], voffB[2];
#pragma unroll
    for (int i = 0; i < 2; ++i) { int R, C; stage_rc(tid * 16 + i * 8192, R, C); const int Rb = Epi::PERM ? ((R & ~31) + perm32(R & 31)) : R;
        voffA[i] = (unsigned)(R * g.lda + C) * 2u; voffB[i] = (unsigned)(Rb * g.ldb + C) * 2u; }
    const size_t kstep = (size_t)(BK * 2);
    const size_t hstepA = (size_t)HALF * g.lda * 2, hstepB = (size_t)HALF * g.ldb * 2;
    const unsigned ldsw = (unsigned)wid * 1024u;
    const int aoff = lds_byte(wr * 64 + fr, fq * 8), boff = lds_byte(wc * 32 + fr, fq * 8);
#define PG8_SA(b, h) (((b) * 2 + (h)) * HTB)
#define PG8_SB(b, h) ((4 + (b) * 2 + (h)) * HTB)
#define PG8_STAGE(bufoff, gbase, voff) do { _Pragma("unroll") for (int _i = 0; _i < 2; ++_i) \
        __builtin_amdgcn_global_load_lds((const unsigned*)((const char*)(gbase) + (voff)[_i]), (LAS unsigned*)(lds + (bufoff) + ldsw + _i * 8192), 16, 0, 0); } while (0)
#define PG8_LDA(dst, b, h) do { _Pragma("unroll") for (int m = 0; m < 4; ++m) _Pragma("unroll") for (int k = 0; k < 2; ++k) dst[m][k] = *(const LAS bf16x8*)(lds + PG8_SA(b, h) + aoff + m * 2048 + k * 1024); } while (0)
#define PG8_LDB(dst, b, h) do { _Pragma("unroll") for (int n = 0; n < 2; ++n) _Pragma("unroll") for (int k = 0; k < 2; ++k) dst[n][k] = *(const LAS bf16x8*)(lds + PG8_SB(b, h) + boff + n * 2048 + k * 1024); } while (0)
#define PG8_MMA(ai, bj, At, Bt) do { __builtin_amdgcn_s_setprio(1); _Pragma("unroll") for (int m = 0; m < 4; ++m) _Pragma("unroll") for (int n = 0; n < 2; ++n) _Pragma("unroll") for (int k = 0; k < 2; ++k) \
        acc[ai][bj][m][n] = __builtin_amdgcn_mfma_f32_16x16x32_bf16(Bt[n][k], At[m][k], acc[ai][bj][m][n], 0, 0, 0); __builtin_amdgcn_s_setprio(0); } while (0)
#define PG8_WAIT_V(n) asm volatile("s_waitcnt vmcnt(" #n ")" ::: "memory")
#define PG8_WAIT_L(n) asm volatile("s_waitcnt lgkmcnt(" #n ")" ::: "memory")
#define PG8_BAR __builtin_amdgcn_s_barrier()
#define PG8_SCHED __builtin_amdgcn_sched_barrier(0)
    Unit cur, nxt; int ui = 0;
    if (!S.next(0, cur)) return;
    f32x4 acc[2][2][4][2];
#pragma unroll
    for (int a = 0; a < 2; ++a)
#pragma unroll
        for (int b = 0; b < 2; ++b)
#pragma unroll
            for (int m = 0; m < 4; ++m)
#pragma unroll
                for (int n = 0; n < 2; ++n) acc[a][b][m][n] = (f32x4){0.f, 0.f, 0.f, 0.f};
    bf16x8 At[4][2], B0[2][2], B1[2][2];
    const char* cA = cur.A; const char* cB = cur.B;
    PG8_STAGE(PG8_SB(0, 0), cB, voffB); PG8_STAGE(PG8_SB(0, 1), cB + hstepB, voffB); PG8_STAGE(PG8_SA(0, 0), cA, voffA); PG8_STAGE(PG8_SA(0, 1), cA + hstepA, voffA);
    if (wr == 1) PG8_BAR;
    PG8_WAIT_V(2); PG8_BAR;
    PG8_STAGE(PG8_SB(1, 0), cB + kstep, voffB); PG8_STAGE(PG8_SA(1, 0), cA + kstep, voffA); PG8_STAGE(PG8_SB(1, 1), cB + hstepB + kstep, voffB);
    PG8_WAIT_V(6); PG8_BAR;
    for (;;) {
        const bool has_next = S.next(ui + 1, nxt);
        const char* nA = has_next ? nxt.A : cA; const char* nB = has_next ? nxt.B : cB;
        for (int t = 0; t < nt; t += 2) {
            const bool last = (t == nt - 2);
            const char* a1 = cA + (size_t)(t + 1) * kstep;
            const char* a2 = last ? nA : cA + (size_t)(t + 2) * kstep; const char* b2 = last ? nB : cB + (size_t)(t + 2) * kstep;
            const char* a3 = a2 + kstep; const char* b3 = b2 + kstep;
            PG8_LDB(B0, 0, 0); PG8_LDB(B1, 0, 1); PG8_SCHED; PG8_LDA(At, 0, 0); PG8_STAGE(PG8_SA(1, 1), a1 + hstepA, voffA);
            PG8_WAIT_V(8); PG8_WAIT_L(0); PG8_BAR; PG8_MMA(0, 0, At, B0); PG8_MMA(0, 1, At, B1); PG8_BAR; PG8_SCHED;
            PG8_LDA(At, 0, 1); PG8_STAGE(PG8_SB(0, 0), b2, voffB); PG8_STAGE(PG8_SB(0, 1), b2 + hstepB, voffB); PG8_STAGE(PG8_SA(0, 0), a2, voffA);
            PG8_WAIT_V(8); PG8_WAIT_L(0); PG8_BAR; PG8_MMA(1, 0, At, B0); PG8_MMA(1, 1, At, B1); PG8_BAR; PG8_SCHED;
            PG8_LDB(B0, 1, 0); PG8_LDB(B1, 1, 1); PG8_SCHED; PG8_LDA(At, 1, 0); PG8_STAGE(PG8_SA(0, 1), a2 + hstepA, voffA);
            PG8_WAIT_V(8); PG8_WAIT_L(0); PG8_BAR; PG8_MMA(0, 0, At, B0); PG8_MMA(0, 1, At, B1); PG8_BAR; PG8_SCHED;
            PG8_LDA(At, 1, 1); PG8_STAGE(PG8_SB(1, 0), b3, voffB); PG8_STAGE(PG8_SB(1, 1), b3 + hstepB, voffB); PG8_STAGE(PG8_SA(1, 0), a3, voffA);
            PG8_WAIT_V(8); PG8_WAIT_L(0); PG8_BAR; PG8_MMA(1, 0, At, B0); PG8_MMA(1, 1, At, B1); PG8_BAR; PG8_SCHED;
        }
        if (wr == 0) PG8_BAR;
        E(acc, cur, wr, wc, lds);
        if (!has_next) break;
#pragma unroll
        for (int a = 0; a < 2; ++a)
#pragma unroll
            for (int b = 0; b < 2; ++b)
#pragma unroll
                for (int m = 0; m < 4; ++m)
#pragma unroll
                    for (int n = 0; n < 2; ++n) acc[a][b][m][n] = (f32x4){0.f, 0.f, 0.f, 0.f};
        cur = nxt; cA = nA; cB = nB; ++ui;
        if (wr == 1) PG8_BAR;
    }
    PG8_WAIT_V(0);
    PG8_BAR;
#undef PG8_SA
#undef PG8_SB
#undef PG8_STAGE
#undef PG8_LDA
#undef PG8_LDB
#undef PG8_MMA
#undef PG8_WAIT_V
#undef PG8_WAIT_L
#undef PG8_SCHED
}

struct EpiBf16 {
    static constexpr bool PERM = true;
    bf16* O0; bf16* O1; int ldc; float scale;
    __device__ __forceinline__ void operator()(const f32x4 (&acc)[2][2][4][2], const Unit& u, int wr, int wc, LAS unsigned char*) const {
        const int lane = fresh_lane(), fr = lane & 15, fq = lane >> 4;
        bf16* O = u.aux ? O1 : O0;
        const int row0 = u.pm * BM + wr * 64 + fr, col0 = u.pn * BM + wc * 32 + 8 * fq;
#pragma unroll
        for (int ai = 0; ai < 2; ++ai)
#pragma unroll
            for (int m = 0; m < 4; ++m) { bf16* rowp = O + (size_t)(row0 + ai * HALF + m * 16) * ldc + col0;
#pragma unroll
                for (int bj = 0; bj < 2; ++bj) { const f32x4 v0 = acc[ai][bj][m][0] * scale, v1 = acc[ai][bj][m][1] * scale;
                    u32x4 w; w.x = pk2(v0[0], v0[1]); w.y = pk2(v0[2], v0[3]); w.z = pk2(v1[0], v1[1]); w.w = pk2(v1[2], v1[3]);
                    *(u32x4*)(rowp + bj * HALF) = w; } }
    }
};
struct EpiSwiGLU {
    static constexpr bool PERM = true;
    bf16* H;
    __device__ __forceinline__ void operator()(const f32x4 (&acc)[2][2][4][2], const Unit& u, int wr, int wc, LAS unsigned char*) const {
        const int lane = fresh_lane(), fr = lane & 15, fq = lane >> 4;
        const int row0 = u.pm * BM + wr * 64 + fr, col0 = u.pn * HALF + wc * 32 + 8 * fq;
#pragma unroll
        for (int ai = 0; ai < 2; ++ai)
#pragma unroll
            for (int m = 0; m < 4; ++m) { bf16* rowp = H + (size_t)(row0 + ai * HALF + m * 16) * DEXP + col0;
                float h[8];
#pragma unroll
                for (int n = 0; n < 2; ++n)
#pragma unroll
                    for (int j = 0; j < 4; ++j) { const float gt = acc[ai][0][m][n][j], up = acc[ai][1][m][n][j]; h[n * 4 + j] = gt * sigmoidf_(gt) * up; }
                u32x4 w; w.x = pk2(h[0], h[1]); w.y = pk2(h[2], h[3]); w.z = pk2(h[4], h[5]); w.w = pk2(h[6], h[7]);
                *(u32x4*)rowp = w; }
    }
};
struct EpiSoftmax {
    static constexpr bool PERM = true;
    bf16* P;
    __device__ __forceinline__ void operator()(f32x4 (&acc)[2][2][4][2], const Unit& u, int wr, int wc, LAS unsigned char* lds) const {
        const int lane = fresh_lane(), fr = lane & 15, fq = lane >> 4;
        LAS float* PM = (LAS float*)(lds + EPI_OFF);
        LAS float* PS = (LAS float*)(lds + EPI_OFF + 4096);
        float mx[2][4];
#pragma unroll
        for (int ai = 0; ai < 2; ++ai)
#pragma unroll
            for (int m = 0; m < 4; ++m) { float v = -3.0e38f;
#pragma unroll
                for (int bj = 0; bj < 2; ++bj)
#pragma unroll
                    for (int n = 0; n < 2; ++n)
#pragma unroll
                        for (int j = 0; j < 4; ++j) v = fmaxf(v, acc[ai][bj][m][n][j]);
                v = fmaxf(v, shx(v, 16, lane)); v = fmaxf(v, shx(v, 32, lane));
                if (fq == 0) PM[(ai * HALF + wr * 64 + m * 16 + fr) * 4 + wc] = v; }
        LDS_WAIT(); __builtin_amdgcn_s_barrier(); asm volatile("" ::: "memory");
#pragma unroll
        for (int ai = 0; ai < 2; ++ai)
#pragma unroll
            for (int m = 0; m < 4; ++m) { const f32x4 pm4 = *(const LAS f32x4*)(PM + (ai * HALF + wr * 64 + m * 16 + fr) * 4);
                const float rm = fmaxf(fmaxf(pm4[0], pm4[1]), fmaxf(pm4[2], pm4[3])); float s = 0.f;
#pragma unroll
                for (int bj = 0; bj < 2; ++bj)
#pragma unroll
                    for (int n = 0; n < 2; ++n)
#pragma unroll
                        for (int j = 0; j < 4; ++j) { const float ev = __expf(acc[ai][bj][m][n][j] - rm); acc[ai][bj][m][n][j] = ev; s += ev; }
                s += shx(s, 16, lane); s += shx(s, 32, lane);
                if (fq == 0) PS[(ai * HALF + wr * 64 + m * 16 + fr) * 4 + wc] = s; }
        LDS_WAIT(); __builtin_amdgcn_s_barrier(); asm volatile("" ::: "memory");
        const int row0 = u.pm * BM + wr * 64 + fr, col0 = u.pn * BM + wc * 32 + 8 * fq;
#pragma unroll
        for (int ai = 0; ai < 2; ++ai)
#pragma unroll
            for (int m = 0; m < 4; ++m) { const f32x4 ps4 = *(const LAS f32x4*)(PS + (ai * HALF + wr * 64 + m * 16 + fr) * 4);
                const float inv = 1.0f / ((ps4[0] + ps4[1]) + (ps4[2] + ps4[3]));
                bf16* rowp = P + (size_t)(row0 + ai * HALF + m * 16) * D + col0;
#pragma unroll
                for (int bj = 0; bj < 2; ++bj) { const f32x4 v0 = acc[ai][bj][m][0] * inv, v1 = acc[ai][bj][m][1] * inv; u32x4 w;
                    w.x = pk2(v0[0], v0[1]); w.y = pk2(v0[2], v0[3]); w.z = pk2(v1[0], v1[1]); w.w = pk2(v1[2], v1[3]);
                    *(u32x4*)(rowp + bj * HALF) = w; } }
    }
};
}

#define XB_TMO      128
#define XB_XCNT(j)  (256  + 64 * (j))
#define XB_XSUB(j)  (1280 + 64 * (j))
#define XB_XGEN(j)  (2304 + 64 * (j))
#define XB_TOP      3328
#define XB_TOPGEN   3392
#define XCD_BAR_WORDS 3456
#define XB_SPIN_CAP (1u << 22)
__device__ __forceinline__ unsigned xb_ld(unsigned* p)              { return __hip_atomic_load(p, __ATOMIC_RELAXED, __HIP_MEMORY_SCOPE_AGENT); }
__device__ __forceinline__ unsigned xb_add(unsigned* p, unsigned v) { return __hip_atomic_fetch_add(p, v, __ATOMIC_RELAXED, __HIP_MEMORY_SCOPE_AGENT); }
__device__ __forceinline__ unsigned xb_xcc_id() { return (unsigned)__builtin_amdgcn_s_getreg((3 << 11) | 20) & 0xFu; }
#define XB_SPIN(cond, bar) do { unsigned _sp = 0; while (cond) { __builtin_amdgcn_s_sleep(1); \
    if ((++_sp & 255u) == 0u) { if (xb_ld(&(bar)[XB_TMO])) break; if (_sp > XB_SPIN_CAP) { atomicAdd(&(bar)[XB_TMO], 1u); break; } } } } while (0)
struct XcdBarrier { unsigned* bar; unsigned x; volatile LAS unsigned* st; };
__device__ __forceinline__ XcdBarrier xcd_barrier_post(unsigned* bar, volatile LAS unsigned* st, int tid) {
    XcdBarrier b; b.bar = bar; b.x = xb_xcc_id(); b.st = st;
    if (tid == 0) (void)xb_add(&bar[XB_XCNT(b.x)], 1u);
    return b;
}
__device__ __forceinline__ void xcd_barrier_complete(unsigned* bar, unsigned x, unsigned& nloc, unsigned& nx) {
    const unsigned G = gridDim.x * gridDim.y * gridDim.z;
    unsigned sum, cnt, mine, sp = 0u;
    for (;;) {
        sum = 0u; cnt = 0u; mine = 0u;
#pragma unroll
        for (unsigned j = 0; j < 16; ++j) { const unsigned c = xb_ld(&bar[XB_XCNT(j)]); sum += c; cnt += (c > 0u) ? 1u : 0u; mine = (j == x) ? c : mine; }
        if (sum == G) break;
        __builtin_amdgcn_s_sleep(1);
        if ((++sp & 255u) == 0u) { if (xb_ld(&bar[XB_TMO])) break; if (sp > XB_SPIN_CAP) { atomicAdd(&bar[XB_TMO], 1u); break; } }
    }
    nloc = mine > 0u ? mine : 1u; nx = cnt > 0u ? cnt : 1u;
}
__device__ __forceinline__ void xcd_barrier(const XcdBarrier& b, int tid) {
    asm volatile("s_waitcnt vmcnt(0)" ::: "memory");
    __syncthreads();
    if (tid == 0) {
        unsigned* bar = b.bar;
        __builtin_amdgcn_s_waitcnt(0);
        unsigned nloc = b.st[0], nx = b.st[1];
        if (nloc == 0u) { xcd_barrier_complete(bar, b.x, nloc, nx); b.st[0] = nloc; b.st[1] = nx; }
        const unsigned old = xb_add(&bar[XB_XSUB(b.x)], 1u);
        const unsigned gen = old / nloc;
        if (old + 1u == (gen + 1u) * nloc) {
            __builtin_amdgcn_fence(__ATOMIC_RELEASE, "agent");
            asm volatile("s_waitcnt vmcnt(0)" ::: "memory");
            const unsigned og = xb_add(&bar[XB_TOP], 1u);
            const unsigned tg = og / nx;
            if (og + 1u == (tg + 1u) * nx) xb_add(&bar[XB_TOPGEN], 1u);
            else XB_SPIN(xb_ld(&bar[XB_TOPGEN]) == tg, bar);
            __builtin_amdgcn_fence(__ATOMIC_ACQUIRE, "agent");
            xb_add(&bar[XB_XGEN(b.x)], 1u);
            asm volatile("s_waitcnt vmcnt(0)" ::: "memory");
        } else {
            XB_SPIN(xb_ld(&bar[XB_XGEN(b.x)]) == gen, bar);
            __builtin_amdgcn_fence(__ATOMIC_ACQUIRE, "agent");
            asm volatile("s_waitcnt vmcnt(0)" ::: "memory");
        }
    }
    __syncthreads();
}

struct Params { const float* in[25]; float* out; unsigned char* ws; int ph_lo, ph_hi; };
enum { I_X = 0, I_MEM, I_WIN, I_LBL, I_HGNW, I_CONVW, I_ALOG, I_DTB, I_GDNW, I_WOUT, I_MLNG, I_MLNB, I_WMQ, I_WMK, I_WMV, I_WMO, I_WGRP, I_BGRP, I_WRT, I_BRT, I_WGATE, I_WUP, I_WDOWN, I_LNG, I_LNB };
constexpr int PH_PRO = 0, PH_KV = 1, PH_L0 = 2, PH_PER_LAYER = 15, N_PHASES = PH_L0 + DEPTH * PH_PER_LAYER;

struct Ctx { LAS unsigned char* lds; unsigned char* ws; const Params* p; int tid, lane, wave, gw, ngw, G, bid; };

__device__ __forceinline__ void transpose_item(const float* W, int ldw, int src_col0, int K, bf16* WT, int dst_row0, LAS float* scr, int k0, int lane) {
#pragma unroll 8
    for (int i = 0; i < 32; ++i) { const int kk = 2 * i + (lane >> 5); scr[kk * 33 + (lane & 31)] = W[(size_t)(k0 + kk) * ldw + src_col0 + (lane & 31)]; }
    LDS_WAIT(); asm volatile("" ::: "memory");
    const int c = lane & 7;
#pragma unroll
    for (int j = 0; j < 4; ++j) { const int n = (lane >> 3) + 8 * j; const LAS float* s = scr + (8 * c) * 33 + n;
        u32x4 o; o.x = pk2(s[0 * 33], s[1 * 33]); o.y = pk2(s[2 * 33], s[3 * 33]); o.z = pk2(s[4 * 33], s[5 * 33]); o.w = pk2(s[6 * 33], s[7 * 33]);
        *(u32x4*)(WT + (size_t)(dst_row0 + n) * K + k0 + 8 * c) = o; }
    LDS_WAIT(); asm volatile("" ::: "memory");
}

__device__ __forceinline__ void phase_prologue(const Ctx& C) {
    const Params& p = *C.p; unsigned char* ws = C.ws;
    LAS float* scr = (LAS float*)(C.lds + C.wave * 16384);
    constexpr int IT_WIN = DEPTH * 16 * 128, IT_SQ = DEPTH * 16 * 32;
    constexpr int NIT = IT_WIN + 5 * IT_SQ;
    for (int it = C.gw; it < NIT; it += C.ngw) {
        int r = it;
        if (r < IT_WIN) { const int l = r / (16 * 128), q = r % (16 * 128), kb = q / 128, nb = q % 128; const int n0 = nb * 32, src = n0 < 3584 ? n0 : n0 + 8;
            transpose_item(p.in[I_WIN] + (size_t)l * D * INW, INW, src, D, (bf16*)(ws + WS_W_IN) + (size_t)l * PW * D, n0, scr, kb * 64, C.lane); continue; }
        r -= IT_WIN;
        const int mat = r / IT_SQ, q2 = r % IT_SQ, l = q2 / 512, q = q2 % 512, kb = q / 32, nb = q % 32;
        const float* src; bf16* dst;
        if (mat == 0) { src = p.in[I_WOUT]; dst = (bf16*)(ws + WS_W_OUT); } else if (mat == 1) { src = p.in[I_WMQ]; dst = (bf16*)(ws + WS_W_Q); }
        else if (mat == 2) { src = p.in[I_WMO]; dst = (bf16*)(ws + WS_W_O); } else if (mat == 3) { src = p.in[I_WMK]; dst = (bf16*)(ws + WS_W_K); }
        else { src = p.in[I_WMV]; dst = (bf16*)(ws + WS_W_V); }
        transpose_item(src + (size_t)l * D * D, D, nb * 32, D, dst + (size_t)l * D * D, nb * 32, scr, kb * 64, C.lane);
    }
    for (int m = C.gw; m < NTOK; m += C.ngw) {
        const f32x4* xr = (const f32x4*)(p.in[I_X] + (size_t)m * D) + C.lane; f32x4* xo = (f32x4*)((float*)(ws + WS_X) + (size_t)m * D) + C.lane;
        u32x2* xb = (u32x2*)((bf16*)(ws + WS_XN) + (size_t)m * D) + C.lane;
#pragma unroll
        for (int j = 0; j < 4; ++j) { const f32x4 v = xr[64 * j]; xo[64 * j] = v; u32x2 w; w.x = pk2(v[0], v[1]); w.y = pk2(v[2], v[3]); xb[64 * j] = w; }
    }
    for (int m = C.gw; m < NMEM; m += C.ngw) {
        const f32x4* xr = (const f32x4*)(p.in[I_MEM] + (size_t)m * D) + C.lane; f32x4 v[4]; float s = 0.f;
#pragma unroll
        for (int j = 0; j < 4; ++j) { v[j] = xr[64 * j]; s += (v[j][0] + v[j][1]) + (v[j][2] + v[j][3]); }
        const float mean = wave_sum(s, C.lane) * (1.f / D); float s2 = 0.f;
#pragma unroll
        for (int j = 0; j < 4; ++j) { v[j] = v[j] - mean; s2 += (v[j][0] * v[j][0] + v[j][1] * v[j][1]) + (v[j][2] * v[j][2] + v[j][3] * v[j][3]); }
        const float rstd = 1.0f / sqrtf(wave_sum(s2, C.lane) * (1.f / D) + LN_EPS);
        u32x2* xb = (u32x2*)((bf16*)(ws + WS_MEMN) + (size_t)m * D) + C.lane;
#pragma unroll
        for (int j = 0; j < 4; ++j) { const f32x4 g = ((const f32x4*)p.in[I_MLNG])[C.lane + 64 * j], b = ((const f32x4*)p.in[I_MLNB])[C.lane + 64 * j]; const f32x4 y = v[j] * rstd * g + b;
            u32x2 w; w.x = pk2(y[0], y[1]); w.y = pk2(y[2], y[3]); xb[64 * j] = w; }
    }
    { float* wab = (float*)(ws + WS_SMALL + SM_WAB);
      for (int i = C.bid * 512 + C.tid; i < DEPTH * 8 * D; i += C.G * 512) { const int l = i / (8 * D), j = (i / D) % 8, k = i % D; wab[i] = p.in[I_WIN][(size_t)l * D * INW + (size_t)k * INW + 3584 + j]; } }
    { float* lb = (float*)(ws + WS_SMALL + SM_LB);
      for (int c = C.bid * 512 + C.tid; c < 512; c += C.G * 512) { float z[DEPTH], mx = -3e38f; for (int l = 0; l < DEPTH; ++l) { z[l] = p.in[I_LBL][l * 512 + c]; mx = fmaxf(mx, z[l]); }
          float s = 0.f; for (int l = 0; l < DEPTH; ++l) { z[l] = expf(z[l] - mx); s += z[l]; }
          float cum = 0.f; for (int l = 0; l < DEPTH; ++l) { if (l > 0) cum += z[l] / s; lb[l * 512 + c] = cum; } } }
}

__device__ __forceinline__ void convert_experts(const Ctx& C, int l) {
    const Params& p = *C.p; LAS float* scr = (LAS float*)(C.lds + C.wave * 16384);
    constexpr int IT_G = NEXP * 16 * 16, IT_D = NEXP * 8 * 32;
    for (int it = C.gw; it < 2 * IT_G + IT_D; it += C.ngw) {
        if (it < 2 * IT_G) { const int s = it / IT_G, r = it % IT_G, e = r / 256, q = r % 256, kb = q / 16, nb = q % 16, n0 = nb * 32;
            const float* src = p.in[s ? I_WUP : I_WGATE] + ((size_t)l * NEXP + e) * D * DEXP;
            transpose_item(src, DEXP, n0, D, (bf16*)(C.ws + WS_GU) + (size_t)e * D * D, 256 * (n0 >> 7) + 128 * s + (n0 & 127), scr, kb * 64, C.lane); }
        else { const int r = it - 2 * IT_G, e = r / 256, q = r % 256, kb = q / 32, nb = q % 32;
            transpose_item(p.in[I_WDOWN] + ((size_t)l * NEXP + e) * DEXP * D, D, nb * 32, DEXP, (bf16*)(C.ws + WS_DN) + (size_t)e * D * DEXP, nb * 32, scr, kb * 64, C.lane); }
    }
}

struct SchedDense {
    const char* A; const char* B; int nM, nN, lda, ldb, G, c;
    __device__ __forceinline__ bool next(int i, pg8::Unit& u) const {
        const long L = (long)i * G + c; if (L >= (long)nM * nN) return false;
        int pm, pn; pg8::tile_of((int)L, nM, nN, pm, pn);
        u.pm = pm; u.pn = pn; u.aux = 0; u.A = A + (size_t)pm * 256 * lda * 2; u.B = B + (size_t)pn * 256 * ldb * 2; return true; }
};
struct SchedKV {
    const char* memn; const char* wk; const char* wv; int G, c;
    __device__ __forceinline__ bool next(int i, pg8::Unit& u) const {
        const long L = (long)i * G + c; if (L >= 512) return false;
        const int which = (int)L >> 8; int pm, pn; pg8::tile_of((int)L & 255, 16, 16, pm, pn);
        u.pm = pm; u.pn = pn; u.aux = which;
        u.A = (which ? wv : memn) + (size_t)pm * 256 * D * 2; u.B = (which ? memn : wk) + (size_t)pn * 256 * D * 2; return true; }
};
struct SchedAttn {
    const char* A; const char* B; int pv, l, G, c;
    __device__ __forceinline__ bool next(int i, pg8::Unit& u) const {
        const long L = (long)i * G + c; if (L >= 512) return false;
        const int pm = (int)L >> 2, h = (int)L & 3, b = pm >> 3;
        u.pm = pm; u.pn = h; u.aux = 0; u.A = A + ((size_t)pm * 256 * D + h * 256) * 2;
        u.B = pv ? B + (((size_t)l * D + h * 256) * 4096 + b * 256) * 2 : B + ((size_t)b * 256 * 4096 + l * D + h * 256) * 2; return true; }
};
struct SchedMoE {
    const char* A; const char* B; const int* tile_tab; int ntiles, lda, ldb, G, c;
    __device__ __forceinline__ bool next(int i, pg8::Unit& u) const {
        const long L = (long)i * G + c; if (L >= (long)ntiles * 4) return false;
        int pm, pn; pg8::tile_of((int)L, ntiles, 4, pm, pn); const int e = __builtin_amdgcn_readfirstlane(tile_tab[16 + pm]);
        u.pm = pm; u.pn = pn; u.aux = 0; u.A = A + (size_t)pm * 256 * lda * 2; u.B = B + ((size_t)e * 1024 + pn * 256) * ldb * 2; return true; }
};

__device__ __forceinline__ void phase_prep(const Ctx& C, int l) {
    const Params& p = *C.p; unsigned char* ws = C.ws;
    const bf16* PROJ = (const bf16*)(ws + WS_PROJ); const bf16* XN = (const bf16*)(ws + WS_XN);
    const float* convw = p.in[I_CONVW] + (size_t)l * 4 * 1536;
    for (int item = C.bid; item < NB * 32; item += C.G) {
        const int b = item >> 5, c = item & 31, t0 = c * 64; const size_t tokb = (size_t)b * T + t0;
        for (int cb = C.wave; cb < 12; cb += 8) {
            const int type = cb >> 2, h = cb & 3, cc = type * 512 + h * 128 + 2 * C.lane;
            float w[4][2];
#pragma unroll
            for (int k = 0; k < 4; ++k) { w[k][0] = convw[k * 1536 + cc]; w[k][1] = convw[k * 1536 + cc + 1]; }
            float xm[3][2];
#pragma unroll
            for (int k = 0; k < 3; ++k) { if (t0 == 0) { xm[k][0] = 0.f; xm[k][1] = 0.f; } else { const unsigned v = *(const unsigned*)(PROJ + (tokb - 3 + k) * PW + 2048 + cc); xm[k][0] = bflo(v); xm[k][1] = bfhi(v); } }
            bf16* dst = (bf16*)(ws + (type == 0 ? WS_QC : type == 1 ? WS_KC : WS_VC)) + h * 128 + 2 * C.lane;
            for (int t = 0; t < 64; ++t) {
                const unsigned v = *(const unsigned*)(PROJ + (tokb + t) * PW + 2048 + cc); const float c0 = bflo(v), c1 = bfhi(v);
                float y0 = w[0][0] * xm[0][0] + w[1][0] * xm[1][0] + w[2][0] * xm[2][0] + w[3][0] * c0;
                float y1 = w[0][1] * xm[0][1] + w[1][1] * xm[1][1] + w[2][1] * xm[2][1] + w[3][1] * c1;
                xm[0][0] = xm[1][0]; xm[0][1] = xm[1][1]; xm[1][0] = xm[2][0]; xm[1][1] = xm[2][1]; xm[2][0] = c0; xm[2][1] = c1;
                y0 = y0 * sigmoidf_(y0); y1 = y1 * sigmoidf_(y1);
                if (type < 2) { const float ss = wave_sum(y0 * y0 + y1 * y1, C.lane); float rn = 1.0f / sqrtf(ss + L2_EPS); if (type == 0) rn *= 0.08838834764831845f; y0 *= rn; y1 *= rn; }
                *(unsigned*)(dst + (tokb + t) * 512) = pk2(y0, y1);
            }
        }
        const float* wab = (const float*)(ws + WS_SMALL + SM_WAB) + (size_t)l * 8 * D;
        for (int tt = 0; tt < 8; ++tt) {
            const size_t tok = tokb + C.wave * 8 + tt; float xv[16];
#pragma unroll
            for (int j = 0; j < 4; ++j) { const u32x2 v = ((const u32x2*)(XN + tok * D))[C.lane + 64 * j]; xv[4 * j] = bflo(v.x); xv[4 * j + 1] = bfhi(v.x); xv[4 * j + 2] = bflo(v.y); xv[4 * j + 3] = bfhi(v.y); }
            float dots[8];
#pragma unroll
            for (int o = 0; o < 8; ++o) { float s = 0.f;
#pragma unroll
                for (int j = 0; j < 4; ++j) { const f32x4 wv = ((const f32x4*)(wab + o * D))[C.lane + 64 * j]; s += xv[4 * j] * wv[0] + xv[4 * j + 1] * wv[1] + xv[4 * j + 2] * wv[2] + xv[4 * j + 3] * wv[3]; }
                dots[o] = wave_sum(s, C.lane); }
            if (C.lane < 4) { const int h = C.lane; float ga = 0.f, gb = 0.f;
#pragma unroll
                for (int o = 0; o < 4; ++o) { ga = (h == o) ? dots[o] : ga; gb = (h == o) ? dots[4 + o] : gb; }
                const float z = ga + p.in[I_DTB][l * 4 + h]; const float sp = fmaxf(z, 0.f) + log1pf(expf(-fabsf(z)));
                ((float*)(ws + WS_G))[tok * 4 + h] = -expf(p.in[I_ALOG][l * 4 + h]) * sp;
                ((float*)(ws + WS_G + G_BETA))[tok * 4 + h] = 1.0f / (1.0f + expf(-gb)); }
        }
    }
}

__device__ __forceinline__ void phase_rec_naive(const Ctx& C, int l) {
    const Params& p = *C.p; unsigned char* ws = C.ws;
    const bf16* PROJ = (const bf16*)(ws + WS_PROJ); bf16* Y = (bf16*)(ws + WS_Y);
    LAS float* qs = (LAS float*)C.lds; LAS float* ks = qs + 2048; LAS float* fs = ks + 2048; LAS float* vs = fs + 2048;
    LAS float* op = vs + 2048;
    LAS float* os = op + 8192;
    LAS float* rp = os + 2048;
    LAS float* gs = rp + 1024;
    const int v = C.tid & 127, dq = C.tid >> 7;
    for (int item = C.bid; item < NB * 8; item += C.G) {
        const int b = item >> 3, h8 = item & 7, gd = h8 >> 2, h = h8 & 3;
        float S[32];
#pragma unroll
        for (int i = 0; i < 32; ++i) S[i] = 0.f;
        const float* lbp = (const float*)(ws + WS_SMALL + SM_LB) + l * 512 + h * 128;
        const float nw0 = p.in[gd ? I_GDNW : I_HGNW][l * 128 + C.lane], nw1 = p.in[gd ? I_GDNW : I_HGNW][l * 128 + C.lane + 64];
        for (int tb = 0; tb < T / 16; ++tb) {
            const size_t tok0 = (size_t)b * T + tb * 16;
#pragma unroll
            for (int i = 0; i < 4; ++i) { const int idx = C.tid + 512 * i, t = idx >> 7, d = idx & 127; const size_t tok = tok0 + t;
                if (!gd) { const float q = bf2f(PROJ[tok * PW + h * 128 + d]), z = bf2f(PROJ[tok * PW + 512 + h * 128 + d]), vi = bf2f(PROJ[tok * PW + 1024 + h * 128 + d]);
                    const float lb = lbp[d], sg = sigmoidf_(z); qs[idx] = q; fs[idx] = lb + (1.f - lb) * sg; ks[idx] = (1.f - lb) * (1.f - sg); vs[idx] = vi; }
                else { qs[idx] = bf2f(((const bf16*)(ws + WS_QC))[tok * 512 + h * 128 + d]); ks[idx] = bf2f(((const bf16*)(ws + WS_KC))[tok * 512 + h * 128 + d]); vs[idx] = bf2f(((const bf16*)(ws + WS_VC))[tok * 512 + h * 128 + d]); } }
            if (gd && C.tid < 16) { gs[C.tid] = ((const float*)(ws + WS_G))[(tok0 + C.tid) * 4 + h]; gs[16 + C.tid] = ((const float*)(ws + WS_G + G_BETA))[(tok0 + C.tid) * 4 + h]; }
            __syncthreads();
            if (!gd) {
                for (int t = 0; t < 16; ++t) { const float vv = vs[t * 128 + v]; float po = 0.f;
#pragma unroll
                    for (int i = 0; i < 32; ++i) { const int d = dq * 32 + i; S[i] = fs[t * 128 + d] * S[i] + ks[t * 128 + d] * vv; po += qs[t * 128 + d] * S[i]; }
                    op[(t * 4 + dq) * 128 + v] = po; }
            } else {
                for (int t = 0; t < 16; ++t) { float pr = 0.f;
#pragma unroll
                    for (int i = 0; i < 32; ++i) pr += ks[t * 128 + dq * 32 + i] * S[i];
                    rp[((t & 1) * 4 + dq) * 128 + v] = pr;
                    __syncthreads();
                    const float r = (rp[((t & 1) * 4 + 0) * 128 + v] + rp[((t & 1) * 4 + 1) * 128 + v]) + (rp[((t & 1) * 4 + 2) * 128 + v] + rp[((t & 1) * 4 + 3) * 128 + v]);
                    const float a = __expf(gs[t]); const float delta = gs[16 + t] * (vs[t * 128 + v] - a * r); float po = 0.f;
#pragma unroll
                    for (int i = 0; i < 32; ++i) { const int d = dq * 32 + i; S[i] = a * S[i] + ks[t * 128 + d] * delta; po += qs[t * 128 + d] * S[i]; }
                    op[(t * 4 + dq) * 128 + v] = po; }
            }
            __syncthreads();
#pragma unroll
            for (int i = 0; i < 4; ++i) { const int idx = C.tid + 512 * i, t = idx >> 7, vv = idx & 127; os[idx] = (op[(t * 4 + 0) * 128 + vv] + op[(t * 4 + 1) * 128 + vv]) + (op[(t * 4 + 2) * 128 + vv] + op[(t * 4 + 3) * 128 + vv]); }
            __syncthreads();
#pragma unroll
            for (int tt = 0; tt < 2; ++tt) { const int t = 2 * C.wave + tt; const size_t tok = tok0 + t; const float o0 = os[t * 128 + C.lane], o1 = os[t * 128 + C.lane + 64];
                const float r = 1.0f / sqrtf(wave_sum(o0 * o0 + o1 * o1, C.lane) * (1.f / 128.f) + RMS_EPS);
                const int gcol = (gd ? 3584 : 1536) + h * 128 + C.lane; const float z0 = bf2f(PROJ[tok * PW + gcol]), z1 = bf2f(PROJ[tok * PW + gcol + 64]);
                const float g0 = gd ? z0 * sigmoidf_(z0) : sigmoidf_(z0), g1 = gd ? z1 * sigmoidf_(z1) : sigmoidf_(z1);
                Y[tok * D + gd * 512 + h * 128 + C.lane] = (bf16)f2bf(o0 * r * nw0 * g0); Y[tok * D + gd * 512 + h * 128 + C.lane + 64] = (bf16)f2bf(o1 * r * nw1 * g1); }
        }
        __syncthreads();
    }
}

template <int MODE>
__device__ __forceinline__ void phase_ln(const Ctx& C, int l, int which, bool last) {
    const Params& p = *C.p; unsigned char* ws = C.ws;
    const f32x4* gp = (const f32x4*)(p.in[I_LNG] + ((size_t)l * 3 + which) * D); const f32x4* bp = (const f32x4*)(p.in[I_LNB] + ((size_t)l * 3 + which) * D);
    f32x4 g[4], bb[4];
#pragma unroll
    for (int j = 0; j < 4; ++j) { g[j] = gp[C.lane + 64 * j]; bb[j] = bp[C.lane + 64 * j]; }
    for (int m = C.gw; m < NTOK; m += C.ngw) {
        f32x4* xr = (f32x4*)((float*)(ws + WS_X) + (size_t)m * D) + C.lane; f32x4 v[4]; float s = 0.f;
        const u32x2* f0; const u32x2* f1 = nullptr; float w0 = 1.f, w1 = 0.f;
        if (MODE == 0) f0 = (const u32x2*)((const bf16*)(ws + WS_F) + (size_t)m * D) + C.lane;
        else { const int d0 = ((const int*)(ws + WS_G + G_DEST))[2 * m], d1 = ((const int*)(ws + WS_G + G_DEST))[2 * m + 1]; w0 = ((const float*)(ws + WS_G + G_GATES))[2 * m]; w1 = ((const float*)(ws + WS_G + G_GATES))[2 * m + 1];
            f0 = (const u32x2*)((const bf16*)(ws + WS_BUF) + (size_t)d0 * D) + C.lane; f1 = (const u32x2*)((const bf16*)(ws + WS_BUF) + (size_t)d1 * D) + C.lane; }
#pragma unroll
        for (int j = 0; j < 4; ++j) { const f32x4 x = xr[64 * j]; const u32x2 a = f0[64 * j]; f32x4 f = (f32x4){bflo(a.x), bfhi(a.x), bflo(a.y), bfhi(a.y)};
            if (MODE == 1) { const u32x2 c = f1[64 * j]; f = f * w0 + (f32x4){bflo(c.x), bfhi(c.x), bflo(c.y), bfhi(c.y)} * w1; }
            v[j] = x * ALPHA + f; s += (v[j][0] + v[j][1]) + (v[j][2] + v[j][3]); }
        const float mean = wave_sum(s, C.lane) * (1.f / D); float s2 = 0.f;
#pragma unroll
        for (int j = 0; j < 4; ++j) { v[j] = v[j] - mean; s2 += (v[j][0] * v[j][0] + v[j][1] * v[j][1]) + (v[j][2] * v[j][2] + v[j][3] * v[j][3]); }
        const float rstd = 1.0f / sqrtf(wave_sum(s2, C.lane) * (1.f / D) + LN_EPS);
        u32x2* xb = (u32x2*)((bf16*)(ws + WS_XN) + (size_t)m * D) + C.lane; f32x4* xo = (f32x4*)(p.out + (size_t)m * D) + C.lane;
#pragma unroll
        for (int j = 0; j < 4; ++j) { const f32x4 y = v[j] * rstd * g[j] + bb[j]; xr[64 * j] = y; u32x2 w; w.x = pk2(y[0], y[1]); w.y = pk2(y[2], y[3]); xb[64 * j] = w; if (last) xo[64 * j] = y; }
    }
}

__device__ __forceinline__ void phase_route(const Ctx& C, int l) {
    const Params& p = *C.p; unsigned char* ws = C.ws;
    LAS float* xs = (LAS float*)C.lds;
    LAS float* wsh = xs + 128 * 65;
    LAS float* lg = wsh + 64 * 36;
    LAS int* es = (LAS int*)(lg + 128 * 36);
    LAS int* rk = es + 256;
    const float* X = (const float*)(ws + WS_X);
    const float* wg = p.in[I_WGRP] + (size_t)l * D * 4; const float* wr_ = p.in[I_WRT] + (size_t)l * D * 32;
    const int t = C.tid & 127, og = C.tid >> 7;
    for (int item = C.bid; item < 256; item += C.G) {
        const size_t tok0 = (size_t)item * 128;
        float acc[9];
#pragma unroll
        for (int i = 0; i < 9; ++i) acc[i] = 0.f;
        for (int k0 = 0; k0 < D; k0 += 64) {
            __syncthreads();
#pragma unroll
            for (int i = 0; i < 16; ++i) { const int idx = C.tid + 512 * i, r = idx >> 6, c = idx & 63; xs[r * 65 + c] = X[(tok0 + r) * D + k0 + c]; }
            for (int idx = C.tid; idx < 64 * 36; idx += 512) { const int k = idx / 36, o = idx % 36; wsh[idx] = o < 4 ? wg[(size_t)(k0 + k) * 4 + o] : wr_[(size_t)(k0 + k) * 32 + o - 4]; }
            __syncthreads();
#pragma unroll 8
            for (int k = 0; k < 64; ++k) { const float xv = xs[t * 65 + k];
#pragma unroll
                for (int i = 0; i < 9; ++i) acc[i] += xv * wsh[k * 36 + og * 9 + i]; }
        }
#pragma unroll
        for (int i = 0; i < 9; ++i) lg[t * 36 + og * 9 + i] = acc[i];
        __syncthreads();
        int e0 = 0, e1 = 0; float w0 = 0.f, w1 = 0.f;
        if (C.tid < 128) {
            float gl[4]; int gsel = 0;
#pragma unroll
            for (int j = 0; j < 4; ++j) gl[j] = lg[C.tid * 36 + j] + p.in[I_BGRP][l * 4 + j];
#pragma unroll
            for (int j = 1; j < 4; ++j) if (gl[j] > gl[gsel]) gsel = j;
            float gsum = 0.f;
#pragma unroll
            for (int j = 0; j < 4; ++j) gsum += expf(gl[j] - gl[gsel]);
            const float ggate = 1.0f / gsum;
            float el[8];
#pragma unroll
            for (int j = 0; j < 8; ++j) el[j] = lg[C.tid * 36 + 4 + gsel * 8 + j] + p.in[I_BRT][l * 32 + gsel * 8 + j];
            int t1 = 0;
#pragma unroll
            for (int j = 1; j < 8; ++j) if (el[j] > el[t1]) t1 = j;
            int t2 = (t1 == 0) ? 1 : 0;
#pragma unroll
            for (int j = 0; j < 8; ++j) if (j != t1 && el[j] > el[t2]) t2 = j;
            const float ex = expf(el[t2] - el[t1]); w0 = ggate / (1.f + ex); w1 = ggate * ex / (1.f + ex);
            e0 = gsel * 8 + t1; e1 = gsel * 8 + t2; es[2 * C.tid] = e0; es[2 * C.tid + 1] = e1;
        }
        __syncthreads();
        if (C.tid < 32) { int cnt = 0; for (int a = 0; a < 256; ++a) if (es[a] == C.tid) { rk[a] = cnt; ++cnt; } ((int*)(ws + WS_SMALL + SM_CNT))[item * 32 + C.tid] = cnt; }
        __syncthreads();
        if (C.tid < 128) { const size_t tok = tok0 + C.tid; int* ro = (int*)(ws + WS_G + G_ROUTE) + tok * 4; ro[0] = e0; ro[1] = e1; ro[2] = rk[2 * C.tid]; ro[3] = rk[2 * C.tid + 1];
            float* gt = (float*)(ws + WS_G + G_GATES) + tok * 2; gt[0] = w0; gt[1] = w1; }
    }
    __syncthreads();
}

__device__ __forceinline__ void phase_dispatch(const Ctx& C) {
    unsigned char* ws = C.ws;
    LAS int* cn = (LAS int*)C.lds;
    LAS int* tot = cn + 8192; LAS int* bef = tot + 32; LAS int* base = bef + 32; LAS int* pst = base + 32; LAS int* dl = pst + 32;
    const int* cnt_all = (const int*)(ws + WS_SMALL + SM_CNT);
    bf16* BUF = (bf16*)(ws + WS_BUF); const bf16* XN = (const bf16*)(ws + WS_XN);
    for (int item = C.bid; item < 256; item += C.G) {
        __syncthreads();
        for (int i = C.tid; i < 8192; i += 512) cn[i] = cnt_all[i];
        __syncthreads();
        if (C.tid < 32) { int s = 0, bsum = 0; for (int b = 0; b < 256; ++b) { const int c = cn[b * 32 + C.tid]; if (b < item) bsum += c; s += c; } tot[C.tid] = s; bef[C.tid] = bsum; }
        __syncthreads();
        if (C.tid == 0) { int ps = 0; for (int e = 0; e < 32; ++e) { pst[e] = ps; base[e] = ps + bef[e]; ps += (tot[e] + 255) & ~255; }
            if (item == 0) { int* tt = (int*)(ws + WS_SMALL + SM_TILE); tt[0] = ps >> 8; for (int e = 0; e < 32; ++e) for (int r = pst[e]; r < pst[e] + ((tot[e] + 255) & ~255); r += 256) tt[16 + (r >> 8)] = e; } }
        __syncthreads();
        if (C.tid < 128) { const size_t tok = (size_t)item * 128 + C.tid; const int* ro = (const int*)(ws + WS_G + G_ROUTE) + tok * 4; const int d0 = base[ro[0]] + ro[2], d1 = base[ro[1]] + ro[3];
            int* dd = (int*)(ws + WS_G + G_DEST) + tok * 2; dd[0] = d0; dd[1] = d1; dl[2 * C.tid] = d0; dl[2 * C.tid + 1] = d1; }
        __syncthreads();
        for (int a = C.wave; a < 256; a += 8) { const size_t tok = (size_t)item * 128 + (a >> 1); const u32x4* src = (const u32x4*)(XN + tok * D); u32x4* dst = (u32x4*)(BUF + (size_t)dl[a] * D);
            dst[C.lane] = src[C.lane]; dst[C.lane + 64] = src[C.lane + 64]; }
        if (item < 32) { const int e = item, r0 = pst[e] + tot[e], r1 = pst[e] + ((tot[e] + 255) & ~255);
            for (int r = r0 + C.wave; r < r1; r += 8) { u32x4* dst = (u32x4*)(BUF + (size_t)r * D); dst[C.lane] = (u32x4){0u, 0u, 0u, 0u}; dst[C.lane + 64] = (u32x4){0u, 0u, 0u, 0u}; } }
    }
    __syncthreads();
}

__global__ void __launch_bounds__(512, 2) trunk_fwd(Params prm) {
    extern __shared__ __attribute__((aligned(16))) unsigned char lds_raw[];
#define MKCTX() Ctx C; { int t_ = wave0 * 64 + fresh_lane(); unsigned char* w_ = prm.ws; asm volatile("" : "+s"(w_)); C.lds = (LAS unsigned char*)lds_raw; C.ws = w_; C.p = &prm; \
    C.tid = t_; C.lane = t_ & 63; C.wave = __builtin_amdgcn_readfirstlane(t_ >> 6); C.G = gridDim.x; C.bid = blockIdx.x; C.gw = C.bid * 8 + C.wave; C.ngw = C.G * 8; } \
    unsigned char* ws = C.ws; LAS unsigned char* ring = C.lds; (void)ws; (void)ring
    const int tid0 = threadIdx.x; const int wave0 = __builtin_amdgcn_readfirstlane(tid0 >> 6);
    volatile LAS unsigned* MISC = (volatile LAS unsigned*)((LAS unsigned char*)lds_raw + MISC_OFF);
    if (tid0 < 32) MISC[tid0] = 0u;
    __syncthreads();
    const int lo = prm.ph_lo, hi = prm.ph_hi;
    unsigned* barw = (unsigned*)(prm.ws + WS_CTL) + 4096;
    XcdBarrier bar; bar.bar = barw; bar.x = 0; bar.st = MISC + 8;
    if (hi - lo > 1) bar = xcd_barrier_post(barw, MISC + 8, tid0);
#ifndef ENMASK
#define ENMASK 0xFFFFFFu
#endif
#define EN(j) (((ENMASK) >> (j)) & 1u)
#define IN(k) (lo <= (k) && (k) < hi)
#define SEAM(k) do { if (IN(k) && IN((k) + 1)) xcd_barrier(bar, wave0 * 64 + fresh_lane()); } while (0)

    if (EN(0) && IN(PH_PRO)) { MKCTX(); phase_prologue(C); } SEAM(PH_PRO);
    if (EN(1) && IN(PH_KV)) { MKCTX();
        pg8::Shape g{D, D, D}; SchedKV S{(const char*)(ws + WS_MEMN), (const char*)(ws + WS_W_K), (const char*)(ws + WS_W_V), C.G, C.bid};
        pg8::EpiBf16 E{(bf16*)(ws + WS_KMEM), (bf16*)(ws + WS_VT), 4096, 1.0f};
        pg8::gemm_phase<pg8::EpiBf16, SchedKV>(ring, g, S, E, C.tid);
    } SEAM(PH_KV);

    for (int l = 0; l < DEPTH; ++l) {
        const int pb = PH_L0 + l * PH_PER_LAYER;
        if (EN(2) && IN(pb + 0)) { MKCTX();
            pg8::Shape g{D, D, D}; SchedDense S{(const char*)(ws + WS_XN), (const char*)(ws + WS_W_IN) + (size_t)l * PW * D * 2, NTOK / 256, PW / 256, D, D, C.G, C.bid};
            pg8::EpiBf16 E{(bf16*)(ws + WS_PROJ), (bf16*)(ws + WS_PROJ), PW, 1.0f};
            pg8::gemm_phase<pg8::EpiBf16, SchedDense>(ring, g, S, E, C.tid);
        } SEAM(pb + 0);
        if (EN(3) && IN(pb + 1)) { MKCTX(); phase_prep(C, l); } SEAM(pb + 1);
        if (EN(4) && IN(pb + 2)) { MKCTX(); phase_rec_naive(C, l); } SEAM(pb + 2);
        if (EN(5) && IN(pb + 3)) { MKCTX();
            pg8::Shape g{D, D, D}; SchedDense S{(const char*)(ws + WS_Y), (const char*)(ws + WS_W_OUT) + (size_t)l * D * D * 2, NTOK / 256, 4, D, D, C.G, C.bid};
            pg8::EpiBf16 E{(bf16*)(ws + WS_F), (bf16*)(ws + WS_F), D, 1.0f};
            pg8::gemm_phase<pg8::EpiBf16, SchedDense>(ring, g, S, E, C.tid);
        } SEAM(pb + 3);
        if (EN(6) && IN(pb + 4)) { MKCTX(); phase_ln<0>(C, l, 0, false); } SEAM(pb + 4);
        if (EN(7) && IN(pb + 5)) { MKCTX();
            pg8::Shape g{D, D, D}; SchedDense S{(const char*)(ws + WS_XN), (const char*)(ws + WS_W_Q) + (size_t)l * D * D * 2, NTOK / 256, 4, D, D, C.G, C.bid};
            pg8::EpiBf16 E{(bf16*)(ws + WS_Q), (bf16*)(ws + WS_Q), D, 0.0625f};
            pg8::gemm_phase<pg8::EpiBf16, SchedDense>(ring, g, S, E, C.tid);
        } SEAM(pb + 5);
        if (EN(8) && IN(pb + 6)) { MKCTX();
            pg8::Shape g{256, D, 4096}; SchedAttn S{(const char*)(ws + WS_Q), (const char*)(ws + WS_KMEM), 0, l, C.G, C.bid};
            pg8::EpiSoftmax E{(bf16*)(ws + WS_P)};
            pg8::gemm_phase<pg8::EpiSoftmax, SchedAttn>(ring, g, S, E, C.tid);
        } SEAM(pb + 6);
        if (EN(9) && IN(pb + 7)) { MKCTX();
            pg8::Shape g{256, D, 4096}; SchedAttn S{(const char*)(ws + WS_P), (const char*)(ws + WS_VT), 1, l, C.G, C.bid};
            pg8::EpiBf16 E{(bf16*)(ws + WS_Y), (bf16*)(ws + WS_Y), D, 1.0f};
            pg8::gemm_phase<pg8::EpiBf16, SchedAttn>(ring, g, S, E, C.tid);
        } SEAM(pb + 7);
        if (EN(10) && IN(pb + 8)) { MKCTX();
            pg8::Shape g{D, D, D}; SchedDense S{(const char*)(ws + WS_Y), (const char*)(ws + WS_W_O) + (size_t)l * D * D * 2, NTOK / 256, 4, D, D, C.G, C.bid};
            pg8::EpiBf16 E{(bf16*)(ws + WS_F), (bf16*)(ws + WS_F), D, 1.0f};
            pg8::gemm_phase<pg8::EpiBf16, SchedDense>(ring, g, S, E, C.tid);
        } SEAM(pb + 8);
        if (EN(11) && IN(pb + 9)) { MKCTX(); phase_ln<0>(C, l, 1, false); } SEAM(pb + 9);
        if (EN(12) && IN(pb + 10)) { MKCTX(); phase_route(C, l); convert_experts(C, l); } SEAM(pb + 10);
        if (EN(13) && IN(pb + 11)) { MKCTX(); phase_dispatch(C); } SEAM(pb + 11);
        if (EN(14) && IN(pb + 12)) { MKCTX();
            const int* tt = (const int*)(ws + WS_SMALL + SM_TILE); const int ntiles = __builtin_amdgcn_readfirstlane(tt[0]);
            pg8::Shape g{D, D, D}; SchedMoE S{(const char*)(ws + WS_BUF), (const char*)(ws + WS_GU), tt, ntiles, D, D, C.G, C.bid};
            pg8::EpiSwiGLU E{(bf16*)(ws + WS_H)};
            pg8::gemm_phase<pg8::EpiSwiGLU, SchedMoE>(ring, g, S, E, C.tid);
        } SEAM(pb + 12);
        if (EN(15) && IN(pb + 13)) { MKCTX();
            const int* tt = (const int*)(ws + WS_SMALL + SM_TILE); const int ntiles = __builtin_amdgcn_readfirstlane(tt[0]);
            pg8::Shape g{DEXP, DEXP, DEXP}; SchedMoE S{(const char*)(ws + WS_H), (const char*)(ws + WS_DN), tt, ntiles, DEXP, DEXP, C.G, C.bid};
            pg8::EpiBf16 E{(bf16*)(ws + WS_BUF), (bf16*)(ws + WS_BUF), D, 1.0f};
            pg8::gemm_phase<pg8::EpiBf16, SchedMoE>(ring, g, S, E, C.tid);
        } SEAM(pb + 13);
        if (EN(16) && IN(pb + 14)) { MKCTX(); phase_ln<1>(C, l, 2, l == DEPTH - 1); } SEAM(pb + 14);
    }
#undef IN
#undef SEAM
}

extern "C" void kernel_launch(void* const* d_in, const int* in_sizes, int n_in, void* d_out, int out_size, void* d_ws, size_t ws_size, hipStream_t stream) {
    static int grid = 0;
    if (grid == 0) {
        if (n_in != 25 || out_size != NTOK * D || ws_size < WS_END) { fprintf(stderr, "kernel_launch: unexpected sizes n_in %d out %d ws %zu (need %zu)\n", n_in, out_size, ws_size, (size_t)WS_END); grid = -1; return; }
        int dev = 0, cus = 0, per_cu = 0;
        if (hipGetDevice(&dev) != hipSuccess || hipDeviceGetAttribute(&cus, hipDeviceAttributeMultiprocessorCount, dev) != hipSuccess) { grid = -1; return; }
        if (hipFuncSetAttribute((const void*)trunk_fwd, hipFuncAttributeMaxDynamicSharedMemorySize, LDS_BYTES) != hipSuccess) { fprintf(stderr, "kernel_launch: hipFuncSetAttribute failed\n"); grid = -1; return; }
        if (hipOccupancyMaxActiveBlocksPerMultiprocessor(&per_cu, (const void*)trunk_fwd, 512, LDS_BYTES) != hipSuccess || per_cu < 1) fprintf(stderr, "kernel_launch: occupancy query reports %d\n", per_cu);
        (void)hipGetLastError();
        grid = cus;
    }
    if (grid < 0) return;
    (void)hipMemsetAsync((char*)d_ws + WS_CTL, 0, CTL_ZERO_BYTES, stream);
    Params a{};
    for (int i = 0; i < 25; ++i) a.in[i] = (const float*)d_in[i];
    a.out = (float*)d_out; a.ws = (unsigned char*)d_ws;
#if MK_ONE_LAUNCH
    a.ph_lo = 0; a.ph_hi = N_PHASES;
    hipLaunchKernelGGL(trunk_fwd, dim3(grid), dim3(512), LDS_BYTES, stream, a);
#else
    for (int ph = 0; ph < N_PHASES; ++ph) { a.ph_lo = ph; a.ph_hi = ph + 1; hipLaunchKernelGGL(trunk_fwd, dim3(grid), dim3(512), LDS_BYTES, stream, a); }
#endif
}
```

```cpp
#include <hip/hip_runtime.h>
#include <cstdio>
#include <cstdint>

#ifndef MK_ONE_LAUNCH
#define MK_ONE_LAUNCH 1
#endif

#define LAS __attribute__((address_space(3)))
#define GAS __attribute__((address_space(1)))
typedef unsigned short bf16;
typedef short bf16x8 __attribute__((ext_vector_type(8)));
typedef float f32x4 __attribute__((ext_vector_type(4)));
typedef float f32x2 __attribute__((ext_vector_type(2)));
typedef unsigned u32x4 __attribute__((ext_vector_type(4)));
typedef unsigned u32x2 __attribute__((ext_vector_type(2)));

constexpr int D = 1024, NB = 16, T = 2048, DEPTH = 4, NTOK = NB * T;
constexpr int MEM = 256, NMEM = NB * MEM;
constexpr int INW = 4104, PW = 4096;
constexpr int NEXP = 32, DEXP = 512;
constexpr int MAXROWS = 74240, MAXTILES = MAXROWS / 256;
constexpr float ALPHA = 1.681792830507429f;
constexpr float LN_EPS = 1e-5f, RMS_EPS = 1e-6f, L2_EPS = 1e-6f;

constexpr size_t MiB = 1u << 20;
constexpr size_t WS_CTL = 0, CTL_ZERO_BYTES = 1 * MiB;
constexpr size_t WS_SMALL = 1 * MiB;
constexpr size_t SM_LB = 0, SM_WAB = 16384, SM_CNT = 262144, SM_TILE = 327680;
constexpr size_t WS_W_IN = 2 * MiB;
constexpr size_t WS_W_OUT = 34 * MiB;
constexpr size_t WS_W_Q = 42 * MiB, WS_W_O = 50 * MiB, WS_W_K = 58 * MiB, WS_W_V = 66 * MiB;
constexpr size_t WS_KMEM = 74 * MiB, WS_VT = 106 * MiB;
constexpr size_t WS_MEMN = 138 * MiB;
constexpr size_t WS_X = 146 * MiB;
constexpr size_t WS_XN = 274 * MiB;
constexpr size_t WS_Y = 338 * MiB;
constexpr size_t WS_F = 402 * MiB;
constexpr size_t WS_PROJ = 466 * MiB;
constexpr size_t WS_Q = WS_PROJ, WS_P = WS_PROJ + 64 * MiB;
constexpr size_t WS_BUF = WS_PROJ, WS_H = WS_PROJ + 146 * MiB;
constexpr size_t WS_GU = 722 * MiB;
constexpr size_t WS_DN = 786 * MiB;
constexpr size_t WS_QC = 818 * MiB, WS_KC = 850 * MiB, WS_VC = 882 * MiB;
constexpr size_t WS_G = 914 * MiB;
constexpr size_t G_BETA = 512 * 1024, G_ROUTE = 1 * MiB, G_GATES = 1536 * 1024, G_DEST = 1792 * 1024;
constexpr size_t WS_END = 916 * MiB;

constexpr int RING_BYTES = 131072;
constexpr int EPI_OFF = RING_BYTES;
constexpr int MISC_OFF = RING_BYTES + 8192;
constexpr int LDS_BYTES = 147456;

#define LDS_WAIT() asm volatile("s_waitcnt lgkmcnt(0)" ::: "memory")
#define VM_WAIT() asm volatile("s_waitcnt vmcnt(0)" ::: "memory")
__device__ __forceinline__ unsigned f2bf(float f) { unsigned u = __builtin_bit_cast(unsigned, f); return (u + 0x7fffu + ((u >> 16) & 1u)) >> 16; }
__device__ __forceinline__ unsigned pk2(float lo, float hi) { return f2bf(lo) | (f2bf(hi) << 16); }
__device__ __forceinline__ float bf2f(unsigned b) { return __builtin_bit_cast(float, b << 16); }
__device__ __forceinline__ float bflo(unsigned w) { return __builtin_bit_cast(float, w << 16); }
__device__ __forceinline__ float bfhi(unsigned w) { return __builtin_bit_cast(float, w & 0xffff0000u); }
__device__ __forceinline__ float shx(float v, int o, int lane) { return __builtin_bit_cast(float, __builtin_amdgcn_ds_bpermute((lane ^ o) << 2, __builtin_bit_cast(int, v))); }
__device__ __forceinline__ float wave_sum(float v, int lane) {
#pragma unroll
    for (int o = 1; o < 64; o <<= 1) v += shx(v, o, lane);
    return v;
}
__device__ __forceinline__ int fresh_lane() { int l; asm volatile("v_mbcnt_lo_u32_b32 %0, -1, 0\n\tv_mbcnt_hi_u32_b32 %0, -1, %0" : "=v"(l)); return l; }
__device__ __forceinline__ float sigmoidf_(float z) { return 1.0f / (1.0f + __expf(-z)); }

namespace pg8 {
constexpr int BM = 256, BK = 64, HALF = 128, HTB = HALF * BK * 2, STAGE_BYTES = 8 * HTB;
__host__ __device__ __forceinline__ int lds_byte(int r, int c) { const int st = (r >> 4) * 2 + (c >> 5), rr = r & 15, cc = c & 31, ob = rr * 64 + cc * 2; return st * 1024 + (ob ^ (((ob >> 9) & 1) << 5)); }
__host__ __device__ __forceinline__ void stage_rc(int b, int& R, int& C) { const int st = b / 1024, sb = b % 1024, swz = sb ^ (((sb >> 9) & 1) << 5); R = (st >> 1) * 16 + swz / 64; C = (st & 1) * 32 + (swz % 64) / 2; }
__host__ __device__ __forceinline__ int perm32(int rho) { const int n = rho >> 4, i = rho & 15; return 8 * (i >> 2) + 4 * n + (i & 3); }

struct Unit { const char* A; const char* B; int pm, pn, aux; };
struct Shape { int K, lda, ldb; };

__device__ __forceinline__ void tile_of(int L, int nM, int nN, int& pm, int& pn) {
    const int nwg = nM * nN; int wgid = L;
    { const int q = nwg / 8, r = nwg % 8, xcd = wgid % 8, off = wgid / 8; wgid = (xcd < r ? xcd * (q + 1) : r * (q + 1) + (xcd - r) * q) + off; }
    const int nig = 8 * nN, gid = wgid / nig, fm = gid * 8, gsz = (nM - fm) < 8 ? (nM - fm) : 8;
    pm = fm + ((wgid % nig) % gsz); pn = (wgid % nig) / gsz;
}

template <class Epi, class Sched>
__device__ __forceinline__ void gemm_phase(LAS unsigned char* lds, const Shape g, const Sched& S, const Epi& E, const int tid) {
    const int wid = __builtin_amdgcn_readfirstlane(tid >> 6), lane = tid & 63, wr = wid >> 2, wc = wid & 3, fr = lane & 15, fq = lane >> 4;
    const int K = g.K, nt = K / BK;
    unsigned voffA[2], voffB[2];
#pragma unroll
    for (int i = 0; i < 2; ++i) { int R, C; stage_rc(tid * 16 + i * 8192, R, C); const int Rb = Epi::PERM ? ((R & ~31) + perm32(R & 31)) : R;
        voffA[i] = (unsigned)(R * g.lda + C) * 2u; voffB[i] = (unsigned)(Rb * g.ldb + C) * 2u; }
    const size_t kstep = (size_t)(BK * 2);
    const size_t hstepA = (size_t)HALF * g.lda * 2, hstepB = (size_t)HALF * g.ldb * 2;
    const unsigned ldsw = (unsigned)wid * 1024u;
    const int aoff = lds_byte(wr * 64 + fr, fq * 8), boff = lds_byte(wc * 32 + fr, fq * 8);
#define PG8_SA(b, h) (((b) * 2 + (h)) * HTB)
#define PG8_SB(b, h) ((4 + (b) * 2 + (h)) * HTB)
#define PG8_STAGE(bufoff, gbase, voff) do { _Pragma("unroll") for (int _i = 0; _i < 2; ++_i) \
        __builtin_amdgcn_global_load_lds((const unsigned*)((const char*)(gbase) + (voff)[_i]), (LAS unsigned*)(lds + (bufoff) + ldsw + _i * 8192), 16, 0, 0); } while (0)
#define PG8_LDA(dst, b, h) do { _Pragma("unroll") for (int m = 0; m < 4; ++m) _Pragma("unroll") for (int k = 0; k < 2; ++k) dst[m][k] = *(const LAS bf16x8*)(lds + PG8_SA(b, h) + aoff + m * 2048 + k * 1024); } while (0)
#define PG8_LDB(dst, b, h) do { _Pragma("unroll") for (int n = 0; n < 2; ++n) _Pragma("unroll") for (int k = 0; k < 2; ++k) dst[n][k] = *(const LAS bf16x8*)(lds + PG8_SB(b, h) + boff + n * 2048 + k * 1024); } while (0)
#define PG8_MMA(ai, bj, At, Bt) do { __builtin_amdgcn_s_setprio(1); _Pragma("unroll") for (int m = 0; m < 4; ++m) _Pragma("unroll") for (int n = 0; n < 2; ++n) _Pragma("unroll") for (int k = 0; k < 2; ++k) \
        acc[ai][bj][m][n] = __builtin_amdgcn_mfma_f32_16x16x32_bf16(Bt[n][k], At[m][k], acc[ai][bj][m][n], 0, 0, 0); __builtin_amdgcn_s_setprio(0); } while (0)
#define PG8_WAIT_V(n) asm volatile("s_waitcnt vmcnt(" #n ")" ::: "memory")
#define PG8_WAIT_L(n) asm volatile("s_waitcnt lgkmcnt(" #n ")" ::: "memory")
#define PG8_BAR __builtin_amdgcn_s_barrier()
#define PG8_SCHED __builtin_amdgcn_sched_barrier(0)
    Unit cur, nxt; int ui = 0;
    if (!S.next(0, cur)) return;
    f32x4 acc[2][2][4][2];
#pragma unroll
    for (int a = 0; a < 2; ++a)
#pragma unroll
        for (int b = 0; b < 2; ++b)
#pragma unroll
            for (int m = 0; m < 4; ++m)
#pragma unroll
                for (int n = 0; n < 2; ++n) acc[a][b][m][n] = (f32x4){0.f, 0.f, 0.f, 0.f};
    bf16x8 At[4][2], B0[2][2], B1[2][2];
    const char* cA = cur.A; const char* cB = cur.B;
    PG8_STAGE(PG8_SB(0, 0), cB, voffB); PG8_STAGE(PG8_SB(0, 1), cB + hstepB, voffB); PG8_STAGE(PG8_SA(0, 0), cA, voffA); PG8_STAGE(PG8_SA(0, 1), cA + hstepA, voffA);
    if (wr == 1) PG8_BAR;
    PG8_WAIT_V(2); PG8_BAR;
    PG8_STAGE(PG8_SB(1, 0), cB + kstep, voffB); PG8_STAGE(PG8_SA(1, 0), cA + kstep, voffA); PG8_STAGE(PG8_SB(1, 1), cB + hstepB + kstep, voffB);
    PG8_WAIT_V(6); PG8_BAR;
    for (;;) {
        const bool has_next = S.next(ui + 1, nxt);
        const char* nA = has_next ? nxt.A : cA; const char* nB = has_next ? nxt.B : cB;
        for (int t = 0; t < nt; t += 2) {
            const bool last = (t == nt - 2);
            const char* a1 = cA + (size_t)(t + 1) * kstep;
            const char* a2 = last ? nA : cA + (size_t)(t + 2) * kstep; const char* b2 = last ? nB : cB + (size_t)(t + 2) * kstep;
            const char* a3 = a2 + kstep; const char* b3 = b2 + kstep;
            PG8_LDB(B0, 0, 0); PG8_LDB(B1, 0, 1); PG8_SCHED; PG8_LDA(At, 0, 0); PG8_STAGE(PG8_SA(1, 1), a1 + hstepA, voffA);
            PG8_WAIT_V(8); PG8_WAIT_L(0); PG8_BAR; PG8_MMA(0, 0, At, B0); PG8_MMA(0, 1, At, B1); PG8_BAR; PG8_SCHED;
            PG8_LDA(At, 0, 1); PG8_STAGE(PG8_SB(0, 0), b2, voffB); PG8_STAGE(PG8_SB(0, 1), b2 + hstepB, voffB); PG8_STAGE(PG8_SA(0, 0), a2, voffA);
            PG8_WAIT_V(8); PG8_WAIT_L(0); PG8_BAR; PG8_MMA(1, 0, At, B0); PG8_MMA(1, 1, At, B1); PG8_BAR; PG8_SCHED;
            PG8_LDB(B0, 1, 0); PG8_LDB(B1, 1, 1); PG8_SCHED; PG8_LDA(At, 1, 0); PG8_STAGE(PG8_SA(0, 1), a2 + hstepA, voffA);
            PG8_WAIT_V(8); PG8_WAIT_L(0); PG8_BAR; PG8_MMA(0, 0, At, B0); PG8_MMA(0, 1, At, B1); PG8_BAR; PG8_SCHED;
            PG8_LDA(At, 1, 1); PG8_STAGE(PG8_SB(1, 0), b3, voffB); PG8_STAGE(PG8_SB(1, 1), b3 + hstepB, voffB); PG8_STAGE(PG8_SA(1, 0), a3, voffA);
            PG8_WAIT_V(8); PG8_WAIT_L(0); PG8_BAR; PG8_MMA(1, 0, At, B0); PG8_MMA(1, 1, At, B1); PG8_BAR; PG8_SCHED;
        }
        if (wr == 0) PG8_BAR;
        E(acc, cur, wr, wc, lds);
        if (!has_next) break;
#pragma unroll
        for (int a = 0; a < 2; ++a)
#pragma unroll
            for (int b = 0; b < 2; ++b)
#pragma unroll
                for (int m = 0; m < 4; ++m)
#pragma unroll
                    for (int n = 0; n < 2; ++n) acc[a][b][m][n] = (f32x4){0.f, 0.f, 0.f, 0.f};
        cur = nxt; cA = nA; cB = nB; ++ui;
        if (wr == 1) PG8_BAR;
    }
    PG8_WAIT_V(0);
    PG8_BAR;
#undef PG8_SA
#undef PG8_SB
#undef PG8_STAGE
#undef PG8_LDA
#undef PG8_LDB
#undef PG8_MMA
#undef PG8_WAIT_V
#undef PG8_WAIT_L
#undef PG8_SCHED
}

struct EpiBf16 {
    static constexpr bool PERM = true;
    bf16* O0; bf16* O1; int ldc; float scale;
    __device__ __forceinline__ void operator()(const f32x4 (&acc)[2][2][4][2], const Unit& u, int wr, int wc, LAS unsigned char*) const {
        const int lane = fresh_lane(), fr = lane & 15, fq = lane >> 4;
        bf16* O = u.aux ? O1 : O0;
        const int row0 = u.pm * BM + wr * 64 + fr, col0 = u.pn * BM + wc * 32 + 8 * fq;
#pragma unroll
        for (int ai = 0; ai < 2; ++ai)
#pragma unroll
            for (int m = 0; m < 4; ++m) { bf16* rowp = O + (size_t)(row0 + ai * HALF + m * 16) * ldc + col0;
#pragma unroll
                for (int bj = 0; bj < 2; ++bj) { const f32x4 v0 = acc[ai][bj][m][0] * scale, v1 = acc[ai][bj][m][1] * scale;
                    u32x4 w; w.x = pk2(v0[0], v0[1]); w.y = pk2(v0[2], v0[3]); w.z = pk2(v1[0], v1[1]); w.w = pk2(v1[2], v1[3]);
                    *(u32x4*)(rowp + bj * HALF) = w; } }
    }
};
struct EpiSwiGLU {
    static constexpr bool PERM = true;
    bf16* H;
    __device__ __forceinline__ void operator()(const f32x4 (&acc)[2][2][4][2], const Unit& u, int wr, int wc, LAS unsigned char*) const {
        const int lane = fresh_lane(), fr = lane & 15, fq = lane >> 4;
        const int row0 = u.pm * BM + wr * 64 + fr, col0 = u.pn * HALF + wc * 32 + 8 * fq;
#pragma unroll
        for (int ai = 0; ai < 2; ++ai)
#pragma unroll
            for (int m = 0; m < 4; ++m) { bf16* rowp = H + (size_t)(row0 + ai * HALF + m * 16) * DEXP + col0;
                float h[8];
#pragma unroll
                for (int n = 0; n < 2; ++n)
#pragma unroll
                    for (int j = 0; j < 4; ++j) { const float gt = acc[ai][0][m][n][j], up = acc[ai][1][m][n][j]; h[n * 4 + j] = gt * sigmoidf_(gt) * up; }
                u32x4 w; w.x = pk2(h[0], h[1]); w.y = pk2(h[2], h[3]); w.z = pk2(h[4], h[5]); w.w = pk2(h[6], h[7]);
                *(u32x4*)rowp = w; }
    }
};
struct EpiSoftmax {
    static constexpr bool PERM = true;
    bf16* P;
    __device__ __forceinline__ void operator()(f32x4 (&acc)[2][2][4][2], const Unit& u, int wr, int wc, LAS unsigned char* lds) const {
        const int lane = fresh_lane(), fr = lane & 15, fq = lane >> 4;
        LAS float* PM = (LAS float*)(lds + EPI_OFF);
        LAS float* PS = (LAS float*)(lds + EPI_OFF + 4096);
        float mx[2][4];
#pragma unroll
        for (int ai = 0; ai < 2; ++ai)
#pragma unroll
            for (int m = 0; m < 4; ++m) { float v = -3.0e38f;
#pragma unroll
                for (int bj = 0; bj < 2; ++bj)
#pragma unroll
                    for (int n = 0; n < 2; ++n)
#pragma unroll
                        for (int j = 0; j < 4; ++j) v = fmaxf(v, acc[ai][bj][m][n][j]);
                v = fmaxf(v, shx(v, 16, lane)); v = fmaxf(v, shx(v, 32, lane));
                if (fq == 0) PM[(ai * HALF + wr * 64 + m * 16 + fr) * 4 + wc] = v; }
        LDS_WAIT(); __builtin_amdgcn_s_barrier(); asm volatile("" ::: "memory");
#pragma unroll
        for (int ai = 0; ai < 2; ++ai)
#pragma unroll
            for (int m = 0; m < 4; ++m) { const f32x4 pm4 = *(const LAS f32x4*)(PM + (ai * HALF + wr * 64 + m * 16 + fr) * 4);
                const float rm = fmaxf(fmaxf(pm4[0], pm4[1]), fmaxf(pm4[2], pm4[3])); float s = 0.f;
#pragma unroll
                for (int bj = 0; bj < 2; ++bj)
#pragma unroll
                    for (int n = 0; n < 2; ++n)
#pragma unroll
                        for (int j = 0; j < 4; ++j) { const float ev = __expf(acc[ai][bj][m][n][j] - rm); acc[ai][bj][m][n][j] = ev; s += ev; }
                s += shx(s, 16, lane); s += shx(s, 32, lane);
                if (fq == 0) PS[(ai * HALF + wr * 64 + m * 16 + fr) * 4 + wc] = s; }
        LDS_WAIT(); __builtin_amdgcn_s_barrier(); asm volatile("" ::: "memory");
        const int row0 = u.pm * BM + wr * 64 + fr, col0 = u.pn * BM + wc * 32 + 8 * fq;
#pragma unroll
        for (int ai = 0; ai < 2; ++ai)
#pragma unroll
            for (int m = 0; m < 4; ++m) { const f32x4 ps4 = *(const LAS f32x4*)(PS + (ai * HALF + wr * 64 + m * 16 + fr) * 4);
                const float inv = 1.0f / ((ps4[0] + ps4[1]) + (ps4[2] + ps4[3]));
                bf16* rowp = P + (size_t)(row0 + ai * HALF + m * 16) * D + col0;
#pragma unroll
                for (int bj = 0; bj < 2; ++bj) { const f32x4 v0 = acc[ai][bj][m][0] * inv, v1 = acc[ai][bj][m][1] * inv; u32x4 w;
                    w.x = pk2(v0[0], v0[1]); w.y = pk2(v0[2], v0[3]); w.z = pk2(v1[0], v1[1]); w.w = pk2(v1[2], v1[3]);
                    *(u32x4*)(rowp + bj * HALF) = w; } }
    }
};
}

#define XB_TMO      128
#define XB_XCNT(j)  (256  + 64 * (j))
#define XB_XSUB(j)  (1280 + 64 * (j))
#define XB_XGEN(j)  (2304 + 64 * (j))
#define XB_TOP      3328
#define XB_TOPGEN   3392
#define XCD_BAR_WORDS 3456
#define XB_SPIN_CAP (1u << 22)
__device__ __forceinline__ unsigned xb_ld(unsigned* p)              { return __hip_atomic_load(p, __ATOMIC_RELAXED, __HIP_MEMORY_SCOPE_AGENT); }
__device__ __forceinline__ unsigned xb_add(unsigned* p, unsigned v) { return __hip_atomic_fetch_add(p, v, __ATOMIC_RELAXED, __HIP_MEMORY_SCOPE_AGENT); }
__device__ __forceinline__ unsigned xb_xcc_id() { return (unsigned)__builtin_amdgcn_s_getreg((3 << 11) | 20) & 0xFu; }
#define XB_SPIN(cond, bar) do { unsigned _sp = 0; while (cond) { __builtin_amdgcn_s_sleep(1); \
    if ((++_sp & 255u) == 0u) { if (xb_ld(&(bar)[XB_TMO])) break; if (_sp > XB_SPIN_CAP) { atomicAdd(&(bar)[XB_TMO], 1u); break; } } } } while (0)
struct XcdBarrier { unsigned* bar; unsigned x; volatile LAS unsigned* st; };
__device__ __forceinline__ XcdBarrier xcd_barrier_post(unsigned* bar, volatile LAS unsigned* st, int tid) {
    XcdBarrier b; b.bar = bar; b.x = xb_xcc_id(); b.st = st;
    if (tid == 0) (void)xb_add(&bar[XB_XCNT(b.x)], 1u);
    return b;
}
__device__ __forceinline__ void xcd_barrier_complete(unsigned* bar, unsigned x, unsigned& nloc, unsigned& nx) {
    const unsigned G = gridDim.x * gridDim.y * gridDim.z;
    unsigned sum, cnt, mine, sp = 0u;
    for (;;) {
        sum = 0u; cnt = 0u; mine = 0u;
#pragma unroll
        for (unsigned j = 0; j < 16; ++j) { const unsigned c = xb_ld(&bar[XB_XCNT(j)]); sum += c; cnt += (c > 0u) ? 1u : 0u; mine = (j == x) ? c : mine; }
        if (sum == G) break;
        __builtin_amdgcn_s_sleep(1);
        if ((++sp & 255u) == 0u) { if (xb_ld(&bar[XB_TMO])) break; if (sp > XB_SPIN_CAP) { atomicAdd(&bar[XB_TMO], 1u); break; } }
    }
    nloc = mine > 0u ? mine : 1u; nx = cnt > 0u ? cnt : 1u;
}
__device__ __forceinline__ void xcd_barrier(const XcdBarrier& b, int tid) {
    asm volatile("s_waitcnt vmcnt(0)" ::: "memory");
    __syncthreads();
    if (tid == 0) {
        unsigned* bar = b.bar;
        __builtin_amdgcn_s_waitcnt(0);
        unsigned nloc = b.st[0], nx = b.st[1];
        if (nloc == 0u) { xcd_barrier_complete(bar, b.x, nloc, nx); b.st[0] = nloc; b.st[1] = nx; }
        const unsigned old = xb_add(&bar[XB_XSUB(b.x)], 1u);
        const unsigned gen = old / nloc;
        if (old + 1u == (gen + 1u) * nloc) {
            __builtin_amdgcn_fence(__ATOMIC_RELEASE, "agent");
            asm volatile("s_waitcnt vmcnt(0)" ::: "memory");
            const unsigned og = xb_add(&bar[XB_TOP], 1u);
            const unsigned tg = og / nx;
            if (og + 1u == (tg + 1u) * nx) xb_add(&bar[XB_TOPGEN], 1u);
            else XB_SPIN(xb_ld(&bar[XB_TOPGEN]) == tg, bar);
            __builtin_amdgcn_fence(__ATOMIC_ACQUIRE, "agent");
            xb_add(&bar[XB_XGEN(b.x)], 1u);
            asm volatile("s_waitcnt vmcnt(0)" ::: "memory");
        } else {
            XB_SPIN(xb_ld(&bar[XB_XGEN(b.x)]) == gen, bar);
            __builtin_amdgcn_fence(__ATOMIC_ACQUIRE, "agent");
            asm volatile("s_waitcnt vmcnt(0)" ::: "memory");
        }
    }
    __syncthreads();
}

struct Params { const float* in[25]; float* out; unsigned char* ws; int ph_lo, ph_hi; };
enum { I_X = 0, I_MEM, I_WIN, I_LBL, I_HGNW, I_CONVW, I_ALOG, I_DTB, I_GDNW, I_WOUT, I_MLNG, I_MLNB, I_WMQ, I_WMK, I_WMV, I_WMO, I_WGRP, I_BGRP, I_WRT, I_BRT, I_WGATE, I_WUP, I_WDOWN, I_LNG, I_LNB };
constexpr int PH_PRO = 0, PH_KV = 1, PH_L0 = 2, PH_PER_LAYER = 15, N_PHASES = PH_L0 + DEPTH * PH_PER_LAYER;

struct Ctx { LAS unsigned char* lds; unsigned char* ws; const Params* p; int tid, lane, wave, gw, ngw, G, bid; };

__device__ __forceinline__ void transpose_item(const float* W, int ldw, int src_col0, int K, bf16* WT, int dst_row0, LAS float* scr, int k0, int lane) {
#pragma unroll 8
    for (int i = 0; i < 32; ++i) { const int kk = 2 * i + (lane >> 5); scr[kk * 33 + (lane & 31)] = W[(size_t)(k0 + kk) * ldw + src_col0 + (lane & 31)]; }
    LDS_WAIT(); asm volatile("" ::: "memory");
    const int c = lane & 7;
#pragma unroll
    for (int j = 0; j < 4; ++j) { const int n = (lane >> 3) + 8 * j; const LAS float* s = scr + (8 * c) * 33 + n;
        u32x4 o; o.x = pk2(s[0 * 33], s[1 * 33]); o.y = pk2(s[2 * 33], s[3 * 33]); o.z = pk2(s[4 * 33], s[5 * 33]); o.w = pk2(s[6 * 33], s[7 * 33]);
        *(u32x4*)(WT + (size_t)(dst_row0 + n) * K + k0 + 8 * c) = o; }
    LDS_WAIT(); asm volatile("" ::: "memory");
}

__device__ __forceinline__ void phase_prologue(const Ctx& C) {
    const Params& p = *C.p; unsigned char* ws = C.ws;
    LAS float* scr = (LAS float*)(C.lds + C.wave * 16384);
    constexpr int IT_WIN = DEPTH * 16 * 128, IT_SQ = DEPTH * 16 * 32;
    constexpr int NIT = IT_WIN + 5 * IT_SQ;
    for (int it = C.gw; it < NIT; it += C.ngw) {
        int r = it;
        if (r < IT_WIN) { const int l = r / (16 * 128), q = r % (16 * 128), kb = q / 128, nb = q % 128; const int n0 = nb * 32, src = n0 < 3584 ? n0 : n0 + 8;
            transpose_item(p.in[I_WIN] + (size_t)l * D * INW, INW, src, D, (bf16*)(ws + WS_W_IN) + (size_t)l * PW * D, n0, scr, kb * 64, C.lane); continue; }
        r -= IT_WIN;
        const int mat = r / IT_SQ, q2 = r % IT_SQ, l = q2 / 512, q = q2 % 512, kb = q / 32, nb = q % 32;
        const float* src; bf16* dst;
        if (mat == 0) { src = p.in[I_WOUT]; dst = (bf16*)(ws + WS_W_OUT); } else if (mat == 1) { src = p.in[I_WMQ]; dst = (bf16*)(ws + WS_W_Q); }
        else if (mat == 2) { src = p.in[I_WMO]; dst = (bf16*)(ws + WS_W_O); } else if (mat == 3) { src = p.in[I_WMK]; dst = (bf16*)(ws + WS_W_K); }
        else { src = p.in[I_WMV]; dst = (bf16*)(ws + WS_W_V); }
        transpose_item(src + (size_t)l * D * D, D, nb * 32, D, dst + (size_t)l * D * D, nb * 32, scr, kb * 64, C.lane);
    }
    for (int m = C.gw; m < NTOK; m += C.ngw) {
        const f32x4* xr = (const f32x4*)(p.in[I_X] + (size_t)m * D) + C.lane; f32x4* xo = (f32x4*)((float*)(ws + WS_X) + (size_t)m * D) + C.lane;
        u32x2* xb = (u32x2*)((bf16*)(ws + WS_XN) + (size_t)m * D) + C.lane;
#pragma unroll
        for (int j = 0; j < 4; ++j) { const f32x4 v = xr[64 * j]; xo[64 * j] = v; u32x2 w; w.x = pk2(v[0], v[1]); w.y = pk2(v[2], v[3]); xb[64 * j] = w; }
    }
    for (int m = C.gw; m < NMEM; m += C.ngw) {
        const f32x4* xr = (const f32x4*)(p.in[I_MEM] + (size_t)m * D) + C.lane; f32x4 v[4]; float s = 0.f;
#pragma unroll
        for (int j = 0; j < 4; ++j) { v[j] = xr[64 * j]; s += (v[j][0] + v[j][1]) + (v[j][2] + v[j][3]); }
        const float mean = wave_sum(s, C.lane) * (1.f / D); float s2 = 0.f;
#pragma unroll
        for (int j = 0; j < 4; ++j) { v[j] = v[j] - mean; s2 += (v[j][0] * v[j][0] + v[j][1] * v[j][1]) + (v[j][2] * v[j][2] + v[j][3] * v[j][3]); }
        const float rstd = 1.0f / sqrtf(wave_sum(s2, C.lane) * (1.f / D) + LN_EPS);
        u32x2* xb = (u32x2*)((bf16*)(ws + WS_MEMN) + (size_t)m * D) + C.lane;
#pragma unroll
        for (int j = 0; j < 4; ++j) { const f32x4 g = ((const f32x4*)p.in[I_MLNG])[C.lane + 64 * j], b = ((const f32x4*)p.in[I_MLNB])[C.lane + 64 * j]; const f32x4 y = v[j] * rstd * g + b;
            u32x2 w; w.x = pk2(y[0], y[1]); w.y = pk2(y[2], y[3]); xb[64 * j] = w; }
    }
    { float* wab = (float*)(ws + WS_SMALL + SM_WAB);
      for (int i = C.bid * 512 + C.tid; i < DEPTH * 8 * D; i += C.G * 512) { const int l = i / (8 * D), j = (i / D) % 8, k = i % D; wab[i] = p.in[I_WIN][(size_t)l * D * INW + (size_t)k * INW + 3584 + j]; } }
    { float* lb = (float*)(ws + WS_SMALL + SM_LB);
      for (int c = C.bid * 512 + C.tid; c < 512; c += C.G * 512) { float z[DEPTH], mx = -3e38f; for (int l = 0; l < DEPTH; ++l) { z[l] = p.in[I_LBL][l * 512 + c]; mx = fmaxf(mx, z[l]); }
          float s = 0.f; for (int l = 0; l < DEPTH; ++l) { z[l] = expf(z[l] - mx); s += z[l]; }
          float cum = 0.f; for (int l = 0; l < DEPTH; ++l) { if (l > 0) cum += z[l] / s; lb[l * 512 + c] = cum; } } }
}

__device__ __forceinline__ void convert_experts(const Ctx& C, int l) {
    const Params& p = *C.p; LAS float* scr = (LAS float*)(C.lds + C.wave * 16384);
    constexpr int IT_G = NEXP * 16 * 16, IT_D = NEXP * 8 * 32;
    for (int it = C.gw; it < 2 * IT_G + IT_D; it += C.ngw) {
        if (it < 2 * IT_G) { const int s = it / IT_G, r = it % IT_G, e = r / 256, q = r % 256, kb = q / 16, nb = q % 16, n0 = nb * 32;
            const float* src = p.in[s ? I_WUP : I_WGATE] + ((size_t)l * NEXP + e) * D * DEXP;
            transpose_item(src, DEXP, n0, D, (bf16*)(C.ws + WS_GU) + (size_t)e * D * D, 256 * (n0 >> 7) + 128 * s + (n0 & 127), scr, kb * 64, C.lane); }
        else { const int r = it - 2 * IT_G, e = r / 256, q = r % 256, kb = q / 32, nb = q % 32;
            transpose_item(p.in[I_WDOWN] + ((size_t)l * NEXP + e) * DEXP * D, D, nb * 32, DEXP, (bf16*)(C.ws + WS_DN) + (size_t)e * D * DEXP, nb * 32, scr, kb * 64, C.lane); }
    }
}

struct SchedDense {
    const char* A; const char* B; int nM, nN, lda, ldb, G, c;
    __device__ __forceinline__ bool next(int i, pg8::Unit& u) const {
        const long L = (long)i * G + c; if (L >= (long)nM * nN) return false;
        int pm, pn; pg8::tile_of((int)L, nM, nN, pm, pn);
        u.pm = pm; u.pn = pn; u.aux = 0; u.A = A + (size_t)pm * 256 * lda * 2; u.B = B + (size_t)pn * 256 * ldb * 2; return true; }
};
struct SchedKV {
    const char* memn; const char* wk; const char* wv; int G, c;
    __device__ __forceinline__ bool next(int i, pg8::Unit& u) const {
        const long L = (long)i * G + c; if (L >= 512) return false;
        const int which = (int)L >> 8; int pm, pn; pg8::tile_of((int)L & 255, 16, 16, pm, pn);
        u.pm = pm; u.pn = pn; u.aux = which;
        u.A = (which ? wv : memn) + (size_t)pm * 256 * D * 2; u.B = (which ? memn : wk) + (size_t)pn * 256 * D * 2; return true; }
};
struct SchedAttn {
    const char* A; const char* B; int pv, l, G, c;
    __device__ __forceinline__ bool next(int i, pg8::Unit& u) const {
        const long L = (long)i * G + c; if (L >= 512) return false;
        const int pm = (int)L >> 2, h = (int)L & 3, b = pm >> 3;
        u.pm = pm; u.pn = h; u.aux = 0; u.A = A + ((size_t)pm * 256 * D + h * 256) * 2;
        u.B = pv ? B + (((size_t)l * D + h * 256) * 4096 + b * 256) * 2 : B + ((size_t)b * 256 * 4096 + l * D + h * 256) * 2; return true; }
};
struct SchedMoE {
    const char* A; const char* B; const int* tile_tab; int ntiles, lda, ldb, G, c;
    __device__ __forceinline__ bool next(int i, pg8::Unit& u) const {
        const long L = (long)i * G + c; if (L >= (long)ntiles * 4) return false;
        int pm, pn; pg8::tile_of((int)L, ntiles, 4, pm, pn); const int e = __builtin_amdgcn_readfirstlane(tile_tab[16 + pm]);
        u.pm = pm; u.pn = pn; u.aux = 0; u.A = A + (size_t)pm * 256 * lda * 2; u.B = B + ((size_t)e * 1024 + pn * 256) * ldb * 2; return true; }
};

__device__ __forceinline__ void phase_prep(const Ctx& C, int l) {
    const Params& p = *C.p; unsigned char* ws = C.ws;
    const bf16* PROJ = (const bf16*)(ws + WS_PROJ); const bf16* XN = (const bf16*)(ws + WS_XN);
    const float* convw = p.in[I_CONVW] + (size_t)l * 4 * 1536;
    for (int item = C.bid; item < NB * 32; item += C.G) {
        const int b = item >> 5, c = item & 31, t0 = c * 64; const size_t tokb = (size_t)b * T + t0;
        for (int cb = C.wave; cb < 12; cb += 8) {
            const int type = cb >> 2, h = cb & 3, cc = type * 512 + h * 128 + 2 * C.lane;
            float w[4][2];
#pragma unroll
            for (int k = 0; k < 4; ++k) { w[k][0] = convw[k * 1536 + cc]; w[k][1] = convw[k * 1536 + cc + 1]; }
            float xm[3][2];
#pragma unroll
            for (int k = 0; k < 3; ++k) { if (t0 == 0) { xm[k][0] = 0.f; xm[k][1] = 0.f; } else { const unsigned v = *(const unsigned*)(PROJ + (tokb - 3 + k) * PW + 2048 + cc); xm[k][0] = bflo(v); xm[k][1] = bfhi(v); } }
            bf16* dst = (bf16*)(ws + (type == 0 ? WS_QC : type == 1 ? WS_KC : WS_VC)) + h * 128 + 2 * C.lane;
            for (int t = 0; t < 64; ++t) {
                const unsigned v = *(const unsigned*)(PROJ + (tokb + t) * PW + 2048 + cc); const float c0 = bflo(v), c1 = bfhi(v);
                float y0 = w[0][0] * xm[0][0] + w[1][0] * xm[1][0] + w[2][0] * xm[2][0] + w[3][0] * c0;
                float y1 = w[0][1] * xm[0][1] + w[1][1] * xm[1][1] + w[2][1] * xm[2][1] + w[3][1] * c1;
                xm[0][0] = xm[1][0]; xm[0][1] = xm[1][1]; xm[1][0] = xm[2][0]; xm[1][1] = xm[2][1]; xm[2][0] = c0; xm[2][1] = c1;
                y0 = y0 * sigmoidf_(y0); y1 = y1 * sigmoidf_(y1);
                if (type < 2) { const float ss = wave_sum(y0 * y0 + y1 * y1, C.lane); float rn = 1.0f / sqrtf(ss + L2_EPS); if (type == 0) rn *= 0.08838834764831845f; y0 *= rn; y1 *= rn; }
                *(unsigned*)(dst + (tokb + t) * 512) = pk2(y0, y1);
            }
        }
        const float* wab = (const float*)(ws + WS_SMALL + SM_WAB) + (size_t)l * 8 * D;
        for (int tt = 0; tt < 8; ++tt) {
            const size_t tok = tokb + C.wave * 8 + tt; float xv[16];
#pragma unroll
            for (int j = 0; j < 4; ++j) { const u32x2 v = ((const u32x2*)(XN + tok * D))[C.lane + 64 * j]; xv[4 * j] = bflo(v.x); xv[4 * j + 1] = bfhi(v.x); xv[4 * j + 2] = bflo(v.y); xv[4 * j + 3] = bfhi(v.y); }
            float dots[8];
#pragma unroll
            for (int o = 0; o < 8; ++o) { float s = 0.f;
#pragma unroll
                for (int j = 0; j < 4; ++j) { const f32x4 wv = ((const f32x4*)(wab + o * D))[C.lane + 64 * j]; s += xv[4 * j] * wv[0] + xv[4 * j + 1] * wv[1] + xv[4 * j + 2] * wv[2] + xv[4 * j + 3] * wv[3]; }
                dots[o] = wave_sum(s, C.lane); }
            if (C.lane < 4) { const int h = C.lane; float ga = 0.f, gb = 0.f;
#pragma unroll
                for (int o = 0; o < 4; ++o) { ga = (h == o) ? dots[o] : ga; gb = (h == o) ? dots[4 + o] : gb; }
                const float z = ga + p.in[I_DTB][l * 4 + h]; const float sp = fmaxf(z, 0.f) + log1pf(expf(-fabsf(z)));
                ((float*)(ws + WS_G))[tok * 4 + h] = -expf(p.in[I_ALOG][l * 4 + h]) * sp;
                ((float*)(ws + WS_G + G_BETA))[tok * 4 + h] = 1.0f / (1.0f + expf(-gb)); }
        }
    }
}

__device__ __forceinline__ void phase_rec_naive(const Ctx& C, int l) {
    const Params& p = *C.p; unsigned char* ws = C.ws;
    const bf16* PROJ = (const bf16*)(ws + WS_PROJ); bf16* Y = (bf16*)(ws + WS_Y);
    LAS float* qs = (LAS float*)C.lds; LAS float* ks = qs + 2048; LAS float* fs = ks + 2048; LAS float* vs = fs + 2048;
    LAS float* op = vs + 2048;
    LAS float* os = op + 8192;
    LAS float* rp = os + 2048;
    LAS float* gs = rp + 1024;
    const int v = C.tid & 127, dq = C.tid >> 7;
    for (int item = C.bid; item < NB * 8; item += C.G) {
        const int b = item >> 3, h8 = item & 7, gd = h8 >> 2, h = h8 & 3;
        float S[32];
#pragma unroll
        for (int i = 0; i < 32; ++i) S[i] = 0.f;
        const float* lbp = (const float*)(ws + WS_SMALL + SM_LB) + l * 512 + h * 128;
        const float nw0 = p.in[gd ? I_GDNW : I_HGNW][l * 128 + C.lane], nw1 = p.in[gd ? I_GDNW : I_HGNW][l * 128 + C.lane + 64];
        for (int tb = 0; tb < T / 16; ++tb) {
            const size_t tok0 = (size_t)b * T + tb * 16;
#pragma unroll
            for (int i = 0; i < 4; ++i) { const int idx = C.tid + 512 * i, t = idx >> 7, d = idx & 127; const size_t tok = tok0 + t;
                if (!gd) { const float q = bf2f(PROJ[tok * PW + h * 128 + d]), z = bf2f(PROJ[tok * PW + 512 + h * 128 + d]), vi = bf2f(PROJ[tok * PW + 1024 + h * 128 + d]);
                    const float lb = lbp[d], sg = sigmoidf_(z); qs[idx] = q; fs[idx] = lb + (1.f - lb) * sg; ks[idx] = (1.f - lb) * (1.f - sg); vs[idx] = vi; }
                else { qs[idx] = bf2f(((const bf16*)(ws + WS_QC))[tok * 512 + h * 128 + d]); ks[idx] = bf2f(((const bf16*)(ws + WS_KC))[tok * 512 + h * 128 + d]); vs[idx] = bf2f(((const bf16*)(ws + WS_VC))[tok * 512 + h * 128 + d]); } }
            if (gd && C.tid < 16) { gs[C.tid] = ((const float*)(ws + WS_G))[(tok0 + C.tid) * 4 + h]; gs[16 + C.tid] = ((const float*)(ws + WS_G + G_BETA))[(tok0 + C.tid) * 4 + h]; }
            __syncthreads();
            if (!gd) {
                for (int t = 0; t < 16; ++t) { const float vv = vs[t * 128 + v]; float po = 0.f;
#pragma unroll
                    for (int i = 0; i < 32; ++i) { const int d = dq * 32 + i; S[i] = fs[t * 128 + d] * S[i] + ks[t * 128 + d] * vv; po += qs[t * 128 + d] * S[i]; }
                    op[(t * 4 + dq) * 128 + v] = po; }
            } else {
                for (int t = 0; t < 16; ++t) { float pr = 0.f;
#pragma unroll
                    for (int i = 0; i < 32; ++i) pr += ks[t * 128 + dq * 32 + i] * S[i];
                    rp[((t & 1) * 4 + dq) * 128 + v] = pr;
                    __syncthreads();
                    const float r = (rp[((t & 1) * 4 + 0) * 128 + v] + rp[((t & 1) * 4 + 1) * 128 + v]) + (rp[((t & 1) * 4 + 2) * 128 + v] + rp[((t & 1) * 4 + 3) * 128 + v]);
                    const float a = __expf(gs[t]); const float delta = gs[16 + t] * (vs[t * 128 + v] - a * r); float po = 0.f;
#pragma unroll
                    for (int i = 0; i < 32; ++i) { const int d = dq * 32 + i; S[i] = a * S[i] + ks[t * 128 + d] * delta; po += qs[t * 128 + d] * S[i]; }
                    op[(t * 4 + dq) * 128 + v] = po; }
            }
            __syncthreads();
#pragma unroll
            for (int i = 0; i < 4; ++i) { const int idx = C.tid + 512 * i, t = idx >> 7, vv = idx & 127; os[idx] = (op[(t * 4 + 0) * 128 + vv] + op[(t * 4 + 1) * 128 + vv]) + (op[(t * 4 + 2) * 128 + vv] + op[(t * 4 + 3) * 128 + vv]); }
            __syncthreads();
#pragma unroll
            for (int tt = 0; tt < 2; ++tt) { const int t = 2 * C.wave + tt; const size_t tok = tok0 + t; const float o0 = os[t * 128 + C.lane], o1 = os[t * 128 + C.lane + 64];
                const float r = 1.0f / sqrtf(wave_sum(o0 * o0 + o1 * o1, C.lane) * (1.f / 128.f) + RMS_EPS);
                const int gcol = (gd ? 3584 : 1536) + h * 128 + C.lane; const float z0 = bf2f(PROJ[tok * PW + gcol]), z1 = bf2f(PROJ[tok * PW + gcol + 64]);
                const float g0 = gd ? z0 * sigmoidf_(z0) : sigmoidf_(z0), g1 = gd ? z1 * sigmoidf_(z1) : sigmoidf_(z1);
                Y[tok * D + gd * 512 + h * 128 + C.lane] = (bf16)f2bf(o0 * r * nw0 * g0); Y[tok * D + gd * 512 + h * 128 + C.lane + 64] = (bf16)f2bf(o1 * r * nw1 * g1); }
        }
        __syncthreads();
    }
}

template <int MODE>
__device__ __forceinline__ void phase_ln(const Ctx& C, int l, int which, bool last) {
    const Params& p = *C.p; unsigned char* ws = C.ws;
    const f32x4* gp = (const f32x4*)(p.in[I_LNG] + ((size_t)l * 3 + which) * D); const f32x4* bp = (const f32x4*)(p.in[I_LNB] + ((size_t)l * 3 + which) * D);
    f32x4 g[4], bb[4];
#pragma unroll
    for (int j = 0; j < 4; ++j) { g[j] = gp[C.lane + 64 * j]; bb[j] = bp[C.lane + 64 * j]; }
    for (int m = C.gw; m < NTOK; m += C.ngw) {
        f32x4* xr = (f32x4*)((float*)(ws + WS_X) + (size_t)m * D) + C.lane; f32x4 v[4]; float s = 0.f;
        const u32x2* f0; const u32x2* f1 = nullptr; float w0 = 1.f, w1 = 0.f;
        if (MODE == 0) f0 = (const u32x2*)((const bf16*)(ws + WS_F) + (size_t)m * D) + C.lane;
        else { const int d0 = ((const int*)(ws + WS_G + G_DEST))[2 * m], d1 = ((const int*)(ws + WS_G + G_DEST))[2 * m + 1]; w0 = ((const float*)(ws + WS_G + G_GATES))[2 * m]; w1 = ((const float*)(ws + WS_G + G_GATES))[2 * m + 1];
            f0 = (const u32x2*)((const bf16*)(ws + WS_BUF) + (size_t)d0 * D) + C.lane; f1 = (const u32x2*)((const bf16*)(ws + WS_BUF) + (size_t)d1 * D) + C.lane; }
#pragma unroll
        for (int j = 0; j < 4; ++j) { const f32x4 x = xr[64 * j]; const u32x2 a = f0[64 * j]; f32x4 f = (f32x4){bflo(a.x), bfhi(a.x), bflo(a.y), bfhi(a.y)};
            if (MODE == 1) { const u32x2 c = f1[64 * j]; f = f * w0 + (f32x4){bflo(c.x), bfhi(c.x), bflo(c.y), bfhi(c.y)} * w1; }
            v[j] = x * ALPHA + f; s += (v[j][0] + v[j][1]) + (v[j][2] + v[j][3]); }
        const float mean = wave_sum(s, C.lane) * (1.f / D); float s2 = 0.f;
#pragma unroll
        for (int j = 0; j < 4; ++j) { v[j] = v[j] - mean; s2 += (v[j][0] * v[j][0] + v[j][1] * v[j][1]) + (v[j][2] * v[j][2] + v[j][3] * v[j][3]); }
        const float rstd = 1.0f / sqrtf(wave_sum(s2, C.lane) * (1.f / D) + LN_EPS);
        u32x2* xb = (u32x2*)((bf16*)(ws + WS_XN) + (size_t)m * D) + C.lane; f32x4* xo = (f32x4*)(p.out + (size_t)m * D) + C.lane;
#pragma unroll
        for (int j = 0; j < 4; ++j) { const f32x4 y = v[j] * rstd * g[j] + bb[j]; xr[64 * j] = y; u32x2 w; w.x = pk2(y[0], y[1]); w.y = pk2(y[2], y[3]); xb[64 * j] = w; if (last) xo[64 * j] = y; }
    }
}

__device__ __forceinline__ void phase_route(const Ctx& C, int l) {
    const Params& p = *C.p; unsigned char* ws = C.ws;
    LAS float* xs = (LAS float*)C.lds;
    LAS float* wsh = xs + 128 * 65;
    LAS float* lg = wsh + 64 * 36;
    LAS int* es = (LAS int*)(lg + 128 * 36);
    LAS int* rk = es + 256;
    const float* X = (const float*)(ws + WS_X);
    const float* wg = p.in[I_WGRP] + (size_t)l * D * 4; const float* wr_ = p.in[I_WRT] + (size_t)l * D * 32;
    const int t = C.tid & 127, og = C.tid >> 7;
    for (int item = C.bid; item < 256; item += C.G) {
        const size_t tok0 = (size_t)item * 128;
        float acc[9];
#pragma unroll
        for (int i = 0; i < 9; ++i) acc[i] = 0.f;
        for (int k0 = 0; k0 < D; k0 += 64) {
            __syncthreads();
#pragma unroll
            for (int i = 0; i < 16; ++i) { const int idx = C.tid + 512 * i, r = idx >> 6, c = idx & 63; xs[r * 65 + c] = X[(tok0 + r) * D + k0 + c]; }
            for (int idx = C.tid; idx < 64 * 36; idx += 512) { const int k = idx / 36, o = idx % 36; wsh[idx] = o < 4 ? wg[(size_t)(k0 + k) * 4 + o] : wr_[(size_t)(k0 + k) * 32 + o - 4]; }
            __syncthreads();
#pragma unroll 8
            for (int k = 0; k < 64; ++k) { const float xv = xs[t * 65 + k];
#pragma unroll
                for (int i = 0; i < 9; ++i) acc[i] += xv * wsh[k * 36 + og * 9 + i]; }
        }
#pragma unroll
        for (int i = 0; i < 9; ++i) lg[t * 36 + og * 9 + i] = acc[i];
        __syncthreads();
        int e0 = 0, e1 = 0; float w0 = 0.f, w1 = 0.f;
        if (C.tid < 128) {
            float gl[4]; int gsel = 0;
#pragma unroll
            for (int j = 0; j < 4; ++j) gl[j] = lg[C.tid * 36 + j] + p.in[I_BGRP][l * 4 + j];
#pragma unroll
            for (int j = 1; j < 4; ++j) if (gl[j] > gl[gsel]) gsel = j;
            float gsum = 0.f;
#pragma unroll
            for (int j = 0; j < 4; ++j) gsum += expf(gl[j] - gl[gsel]);
            const float ggate = 1.0f / gsum;
            float el[8];
#pragma unroll
            for (int j = 0; j < 8; ++j) el[j] = lg[C.tid * 36 + 4 + gsel * 8 + j] + p.in[I_BRT][l * 32 + gsel * 8 + j];
            int t1 = 0;
#pragma unroll
            for (int j = 1; j < 8; ++j) if (el[j] > el[t1]) t1 = j;
            int t2 = (t1 == 0) ? 1 : 0;
#pragma unroll
            for (int j = 0; j < 8; ++j) if (j != t1 && el[j] > el[t2]) t2 = j;
            const float ex = expf(el[t2] - el[t1]); w0 = ggate / (1.f + ex); w1 = ggate * ex / (1.f + ex);
            e0 = gsel * 8 + t1; e1 = gsel * 8 + t2; es[2 * C.tid] = e0; es[2 * C.tid + 1] = e1;
        }
        __syncthreads();
        if (C.tid < 32) { int cnt = 0; for (int a = 0; a < 256; ++a) if (es[a] == C.tid) { rk[a] = cnt; ++cnt; } ((int*)(ws + WS_SMALL + SM_CNT))[item * 32 + C.tid] = cnt; }
        __syncthreads();
        if (C.tid < 128) { const size_t tok = tok0 + C.tid; int* ro = (int*)(ws + WS_G + G_ROUTE) + tok * 4; ro[0] = e0; ro[1] = e1; ro[2] = rk[2 * C.tid]; ro[3] = rk[2 * C.tid + 1];
            float* gt = (float*)(ws + WS_G + G_GATES) + tok * 2; gt[0] = w0; gt[1] = w1; }
    }
    __syncthreads();
}

__device__ __forceinline__ void phase_dispatch(const Ctx& C) {
    unsigned char* ws = C.ws;
    LAS int* cn = (LAS int*)C.lds;
    LAS int* tot = cn + 8192; LAS int* bef = tot + 32; LAS int* base = bef + 32; LAS int* pst = base + 32; LAS int* dl = pst + 32;
    const int* cnt_all = (const int*)(ws + WS_SMALL + SM_CNT);
    bf16* BUF = (bf16*)(ws + WS_BUF); const bf16* XN = (const bf16*)(ws + WS_XN);
    for (int item = C.bid; item < 256; item += C.G) {
        __syncthreads();
        for (int i = C.tid; i < 8192; i += 512) cn[i] = cnt_all[i];
        __syncthreads();
        if (C.tid < 32) { int s = 0, bsum = 0; for (int b = 0; b < 256; ++b) { const int c = cn[b * 32 + C.tid]; if (b < item) bsum += c; s += c; } tot[C.tid] = s; bef[C.tid] = bsum; }
        __syncthreads();
        if (C.tid == 0) { int ps = 0; for (int e = 0; e < 32; ++e) { pst[e] = ps; base[e] = ps + bef[e]; ps += (tot[e] + 255) & ~255; }
            if (item == 0) { int* tt = (int*)(ws + WS_SMALL + SM_TILE); tt[0] = ps >> 8; for (int e = 0; e < 32; ++e) for (int r = pst[e]; r < pst[e] + ((tot[e] + 255) & ~255); r += 256) tt[16 + (r >> 8)] = e; } }
        __syncthreads();
        if (C.tid < 128) { const size_t tok = (size_t)item * 128 + C.tid; const int* ro = (const int*)(ws + WS_G + G_ROUTE) + tok * 4; const int d0 = base[ro[0]] + ro[2], d1 = base[ro[1]] + ro[3];
            int* dd = (int*)(ws + WS_G + G_DEST) + tok * 2; dd[0] = d0; dd[1] = d1; dl[2 * C.tid] = d0; dl[2 * C.tid + 1] = d1; }
        __syncthreads();
        for (int a = C.wave; a < 256; a += 8) { const size_t tok = (size_t)item * 128 + (a >> 1); const u32x4* src = (const u32x4*)(XN + tok * D); u32x4* dst = (u32x4*)(BUF + (size_t)dl[a] * D);
            dst[C.lane] = src[C.lane]; dst[C.lane + 64] = src[C.lane + 64]; }
        if (item < 32) { const int e = item, r0 = pst[e] + tot[e], r1 = pst[e] + ((tot[e] + 255) & ~255);
            for (int r = r0 + C.wave; r < r1; r += 8) { u32x4* dst = (u32x4*)(BUF + (size_t)r * D); dst[C.lane] = (u32x4){0u, 0u, 0u, 0u}; dst[C.lane + 64] = (u32x4){0u, 0u, 0u, 0u}; } }
    }
    __syncthreads();
}

__global__ void __launch_bounds__(512, 2) trunk_fwd(Params prm) {
    extern __shared__ __attribute__((aligned(16))) unsigned char lds_raw[];
#define MKCTX() Ctx C; { int t_ = wave0 * 64 + fresh_lane(); unsigned char* w_ = prm.ws; asm volatile("" : "+s"(w_)); C.lds = (LAS unsigned char*)lds_raw; C.ws = w_; C.p = &prm; \
    C.tid = t_; C.lane = t_ & 63; C.wave = __builtin_amdgcn_readfirstlane(t_ >> 6); C.G = gridDim.x; C.bid = blockIdx.x; C.gw = C.bid * 8 + C.wave; C.ngw = C.G * 8; } \
    unsigned char* ws = C.ws; LAS unsigned char* ring = C.lds; (void)ws; (void)ring
    const int tid0 = threadIdx.x; const int wave0 = __builtin_amdgcn_readfirstlane(tid0 >> 6);
    volatile LAS unsigned* MISC = (volatile LAS unsigned*)((LAS unsigned char*)lds_raw + MISC_OFF);
    if (tid0 < 32) MISC[tid0] = 0u;
    __syncthreads();
    const int lo = prm.ph_lo, hi = prm.ph_hi;
    unsigned* barw = (unsigned*)(prm.ws + WS_CTL) + 4096;
    XcdBarrier bar; bar.bar = barw; bar.x = 0; bar.st = MISC + 8;
    if (hi - lo > 1) bar = xcd_barrier_post(barw, MISC + 8, tid0);
#ifndef ENMASK
#define ENMASK 0xFFFFFFu
#endif
#define EN(j) (((ENMASK) >> (j)) & 1u)
#define IN(k) (lo <= (k) && (k) < hi)
#define SEAM(k) do { if (IN(k) && IN((k) + 1)) xcd_barrier(bar, wave0 * 64 + fresh_lane()); } while (0)

    if (EN(0) && IN(PH_PRO)) { MKCTX(); phase_prologue(C); } SEAM(PH_PRO);
    if (EN(1) && IN(PH_KV)) { MKCTX();
        pg8::Shape g{D, D, D}; SchedKV S{(const char*)(ws + WS_MEMN), (const char*)(ws + WS_W_K), (const char*)(ws + WS_W_V), C.G, C.bid};
        pg8::EpiBf16 E{(bf16*)(ws + WS_KMEM), (bf16*)(ws + WS_VT), 4096, 1.0f};
        pg8::gemm_phase<pg8::EpiBf16, SchedKV>(ring, g, S, E, C.tid);
    } SEAM(PH_KV);

    for (int l = 0; l < DEPTH; ++l) {
        const int pb = PH_L0 + l * PH_PER_LAYER;
        if (EN(2) && IN(pb + 0)) { MKCTX();
            pg8::Shape g{D, D, D}; SchedDense S{(const char*)(ws + WS_XN), (const char*)(ws + WS_W_IN) + (size_t)l * PW * D * 2, NTOK / 256, PW / 256, D, D, C.G, C.bid};
            pg8::EpiBf16 E{(bf16*)(ws + WS_PROJ), (bf16*)(ws + WS_PROJ), PW, 1.0f};
            pg8::gemm_phase<pg8::EpiBf16, SchedDense>(ring, g, S, E, C.tid);
        } SEAM(pb + 0);
        if (EN(3) && IN(pb + 1)) { MKCTX(); phase_prep(C, l); } SEAM(pb + 1);
        if (EN(4) && IN(pb + 2)) { MKCTX(); phase_rec_naive(C, l); } SEAM(pb + 2);
        if (EN(5) && IN(pb + 3)) { MKCTX();
            pg8::Shape g{D, D, D}; SchedDense S{(const char*)(ws + WS_Y), (const char*)(ws + WS_W_OUT) + (size_t)l * D * D * 2, NTOK / 256, 4, D, D, C.G, C.bid};
            pg8::EpiBf16 E{(bf16*)(ws + WS_F), (bf16*)(ws + WS_F), D, 1.0f};
            pg8::gemm_phase<pg8::EpiBf16, SchedDense>(ring, g, S, E, C.tid);
        } SEAM(pb + 3);
        if (EN(6) && IN(pb + 4)) { MKCTX(); phase_ln<0>(C, l, 0, false); } SEAM(pb + 4);
        if (EN(7) && IN(pb + 5)) { MKCTX();
            pg8::Shape g{D, D, D}; SchedDense S{(const char*)(ws + WS_XN), (const char*)(ws + WS_W_Q) + (size_t)l * D * D * 2, NTOK / 256, 4, D, D, C.G, C.bid};
            pg8::EpiBf16 E{(bf16*)(ws + WS_Q), (bf16*)(ws + WS_Q), D, 0.0625f};
            pg8::gemm_phase<pg8::EpiBf16, SchedDense>(ring, g, S, E, C.tid);
        } SEAM(pb + 5);
        if (EN(8) && IN(pb + 6)) { MKCTX();
            pg8::Shape g{256, D, 4096}; SchedAttn S{(const char*)(ws + WS_Q), (const char*)(ws + WS_KMEM), 0, l, C.G, C.bid};
            pg8::EpiSoftmax E{(bf16*)(ws + WS_P)};
            pg8::gemm_phase<pg8::EpiSoftmax, SchedAttn>(ring, g, S, E, C.tid);
        } SEAM(pb + 6);
        if (EN(9) && IN(pb + 7)) { MKCTX();
            pg8::Shape g{256, D, 4096}; SchedAttn S{(const char*)(ws + WS_P), (const char*)(ws + WS_VT), 1, l, C.G, C.bid};
            pg8::EpiBf16 E{(bf16*)(ws + WS_Y), (bf16*)(ws + WS_Y), D, 1.0f};
            pg8::gemm_phase<pg8::EpiBf16, SchedAttn>(ring, g, S, E, C.tid);
        } SEAM(pb + 7);
        if (EN(10) && IN(pb + 8)) { MKCTX();
            pg8::Shape g{D, D, D}; SchedDense S{(const char*)(ws + WS_Y), (const char*)(ws + WS_W_O) + (size_t)l * D * D * 2, NTOK / 256, 4, D, D, C.G, C.bid};
            pg8::EpiBf16 E{(bf16*)(ws + WS_F), (bf16*)(ws + WS_F), D, 1.0f};
            pg8::gemm_phase<pg8::EpiBf16, SchedDense>(ring, g, S, E, C.tid);
        } SEAM(pb + 8);
        if (EN(11) && IN(pb + 9)) { MKCTX(); phase_ln<0>(C, l, 1, false); } SEAM(pb + 9);
        if (EN(12) && IN(pb + 10)) { MKCTX(); phase_route(C, l); convert_experts(C, l); } SEAM(pb + 10);
        if (EN(13) && IN(pb + 11)) { MKCTX(); phase_dispatch(C); } SEAM(pb + 11);
        if (EN(14) && IN(pb + 12)) { MKCTX();
            const int* tt = (const int*)(ws + WS_SMALL + SM_TILE); const int ntiles = __builtin_amdgcn_readfirstlane(tt[0]);
            pg8::Shape g{D, D, D}; SchedMoE S{(const char*)(ws + WS_BUF), (const char*)(ws + WS_GU), tt, ntiles, D, D, C.G, C.bid};
            pg8::EpiSwiGLU E{(bf16*)(ws + WS_H)};
            pg8::gemm_phase<pg8::EpiSwiGLU, SchedMoE>(ring, g, S, E, C.tid);
        } SEAM(pb + 12);
        if (EN(15) && IN(pb + 13)) { MKCTX();
            const int* tt = (const int*)(ws + WS_SMALL + SM_TILE); const int ntiles = __builtin_amdgcn_readfirstlane(tt[0]);
            pg8::Shape g{DEXP, DEXP, DEXP}; SchedMoE S{(const char*)(ws + WS_H), (const char*)(ws + WS_DN), tt, ntiles, DEXP, DEXP, C.G, C.bid};
            pg8::EpiBf16 E{(bf16*)(ws + WS_BUF), (bf16*)(ws + WS_BUF), D, 1.0f};
            pg8::gemm_phase<pg8::EpiBf16, SchedMoE>(ring, g, S, E, C.tid);
        } SEAM(pb + 13);
        if (EN(16) && IN(pb + 14)) { MKCTX(); phase_ln<1>(C, l, 2, l == DEPTH - 1); } SEAM(pb + 14);
    }
#undef IN
#undef SEAM
}

extern "C" void kernel_launch(void* const* d_in, const int* in_sizes, int n_in, void* d_out, int out_size, void* d_ws, size_t ws_size, hipStream_t stream) {
    static int grid = 0;
    if (grid == 0) {
        if (n_in != 25 || out_size != NTOK * D || ws_size < WS_END) { fprintf(stderr, "kernel_launch: unexpected sizes n_in %d out %d ws %zu (need %zu)\n", n_in, out_size, ws_size, (size_t)WS_END); grid = -1; return; }
        int dev = 0, cus = 0, per_cu = 0;
        if (hipGetDevice(&dev) != hipSuccess || hipDeviceGetAttribute(&cus, hipDeviceAttributeMultiprocessorCount, dev) != hipSuccess) { grid = -1; return; }
        if (hipFuncSetAttribute((const void*)trunk_fwd, hipFuncAttributeMaxDynamicSharedMemorySize, LDS_BYTES) != hipSuccess) { fprintf(stderr, "kernel_launch: hipFuncSetAttribute failed\n"); grid = -1; return; }
        if (hipOccupancyMaxActiveBlocksPerMultiprocessor(&per_cu, (const void*)trunk_fwd, 512, LDS_BYTES) != hipSuccess || per_cu < 1) fprintf(stderr, "kernel_launch: occupancy query reports %d\n", per_cu);
        (void)hipGetLastError();
        grid = cus;
    }
    if (grid < 0) return;
    (void)hipMemsetAsync((char*)d_ws + WS_CTL, 0, CTL_ZERO_BYTES, stream);
    Params a{};
    for (int i = 0; i < 25; ++i) a.in[i] = (const float*)d_in[i];
    a.out = (float*)d_out; a.ws = (unsigned char*)d_ws;
#if MK_ONE_LAUNCH
    a.ph_lo = 0; a.ph_hi = N_PHASES;
    hipLaunchKernelGGL(trunk_fwd, dim3(grid), dim3(512), LDS_BYTES, stream, a);
#else
    for (int ph = 0; ph < N_PHASES; ++ph) { a.ph_lo = ph; a.ph_hi = ph + 1; hipLaunchKernelGGL(trunk_fwd, dim3(grid), dim3(512), LDS_BYTES, stream, a); }
#endif
}
```

```cpp
#include <hip/hip_runtime.h>
#include <cstdio>
#include <cstdint>

#ifndef REC_MODE
#define REC_MODE 2
#endif
#ifndef MK_ONE_LAUNCH
#define MK_ONE_LAUNCH 1
#endif

#define LAS __attribute__((address_space(3)))
#define GAS __attribute__((address_space(1)))
typedef unsigned short bf16;
typedef short bf16x8 __attribute__((ext_vector_type(8)));
typedef float f32x4 __attribute__((ext_vector_type(4)));
typedef float f32x2 __attribute__((ext_vector_type(2)));
typedef unsigned u32x4 __attribute__((ext_vector_type(4)));
typedef unsigned u32x2 __attribute__((ext_vector_type(2)));

constexpr int D = 1024, NB = 16, T = 2048, DEPTH = 4, NTOK = NB * T;
constexpr int MEM = 256, NMEM = NB * MEM;
constexpr int INW = 4104, PW = 4096;
constexpr int NEXP = 32, DEXP = 512;
constexpr int MAXROWS = 74240, MAXTILES = MAXROWS / 256;
constexpr float ALPHA = 1.681792830507429f;
constexpr float LN_EPS = 1e-5f, RMS_EPS = 1e-6f, L2_EPS = 1e-6f;

constexpr size_t MiB = 1u << 20;
constexpr size_t WS_CTL = 0, CTL_ZERO_BYTES = 1 * MiB;
constexpr size_t WS_SMALL = 1 * MiB;
constexpr size_t SM_LB = 0, SM_WAB = 16384, SM_CNT = 262144, SM_TILE = 327680;
constexpr size_t WS_W_IN = 2 * MiB;
constexpr size_t WS_W_OUT = 34 * MiB;
constexpr size_t WS_W_Q = 42 * MiB, WS_W_O = 50 * MiB, WS_W_K = 58 * MiB, WS_W_V = 66 * MiB;
constexpr size_t WS_KMEM = 74 * MiB, WS_VT = 106 * MiB;
constexpr size_t WS_MEMN = 138 * MiB;
constexpr size_t WS_X = 146 * MiB;
constexpr size_t WS_XN = 274 * MiB;
constexpr size_t WS_Y = 338 * MiB;
constexpr size_t WS_F = 402 * MiB;
constexpr size_t WS_PROJ2 = 466 * MiB;
constexpr size_t WS_PROJ1 = 562 * MiB;
constexpr int P1W = 2560, P2W = 1536, C_HQ = 0, C_HF = 512, C_HI = 1024, C_HZ = 1536, C_GZ = 2048;
constexpr size_t WS_PROJ = WS_PROJ2;
constexpr size_t WS_Q = WS_PROJ, WS_P = WS_PROJ + 64 * MiB;
constexpr size_t WS_BUF = WS_PROJ, WS_H = WS_PROJ + 146 * MiB;
constexpr int REC_G = 74752, REC_H = 58368;
constexpr size_t WS_RECG = 402 * MiB, WS_RECH = 916 * MiB;
constexpr size_t WS_GU = 722 * MiB;
constexpr size_t WS_DN = 786 * MiB;
constexpr size_t WS_QC = 818 * MiB, WS_KC = 850 * MiB, WS_VC = 882 * MiB;
constexpr size_t WS_G = 914 * MiB;
constexpr size_t G_BETA = 512 * 1024, G_ROUTE = 1 * MiB, G_GATES = 1536 * 1024, G_DEST = 1792 * 1024;
constexpr size_t WS_END = 1032 * MiB;

constexpr int RING_BYTES = 131072;
constexpr int EPI_OFF = RING_BYTES;
constexpr int MISC_OFF = 162816;
constexpr int LDS_BYTES = 163840;

#define LDS_WAIT() asm volatile("s_waitcnt lgkmcnt(0)" ::: "memory")
#define VM_WAIT() asm volatile("s_waitcnt vmcnt(0)" ::: "memory")
__device__ __forceinline__ unsigned f2bf(float f) { unsigned u = __builtin_bit_cast(unsigned, f); return (u + 0x7fffu + ((u >> 16) & 1u)) >> 16; }
__device__ __forceinline__ unsigned pk2(float lo, float hi) { return f2bf(lo) | (f2bf(hi) << 16); }
__device__ __forceinline__ float bf2f(unsigned b) { return __builtin_bit_cast(float, b << 16); }
__device__ __forceinline__ float bflo(unsigned w) { return __builtin_bit_cast(float, w << 16); }
__device__ __forceinline__ float bfhi(unsigned w) { return __builtin_bit_cast(float, w & 0xffff0000u); }
__device__ __forceinline__ float shx(float v, int o, int lane) { return __builtin_bit_cast(float, __builtin_amdgcn_ds_bpermute((lane ^ o) << 2, __builtin_bit_cast(int, v))); }
__device__ __forceinline__ float wave_sum(float v, int lane) {
#pragma unroll
    for (int o = 1; o < 64; o <<= 1) v += shx(v, o, lane);
    return v;
}
__device__ __forceinline__ int fresh_lane() { int l; asm volatile("v_mbcnt_lo_u32_b32 %0, -1, 0\n\tv_mbcnt_hi_u32_b32 %0, -1, %0" : "=v"(l)); return l; }
__device__ __forceinline__ float sigmoidf_(float z) { return 1.0f / (1.0f + __expf(-z)); }

namespace pg8 {
constexpr int BM = 256, BK = 64, HALF = 128, HTB = HALF * BK * 2, STAGE_BYTES = 8 * HTB;
__host__ __device__ __forceinline__ int lds_byte(int r, int c) { const int st = (r >> 4) * 2 + (c >> 5), rr = r & 15, cc = c & 31, ob = rr * 64 + cc * 2; return st * 1024 + (ob ^ (((ob >> 9) & 1) << 5)); }
__host__ __device__ __forceinline__ void stage_rc(int b, int& R, int& C) { const int st = b / 1024, sb = b % 1024, swz = sb ^ (((sb >> 9) & 1) << 5); R = (st >> 1) * 16 + swz / 64; C = (st & 1) * 32 + (swz % 64) / 2; }
__host__ __device__ __forceinline__ int perm32(int rho) { const int n = rho >> 4, i = rho & 15; return 8 * (i >> 2) + 4 * n + (i & 3); }

struct Unit { const char* A; const char* B; int pm, pn, aux; };
struct Shape { int K, lda, ldb; };

__device__ __forceinline__ void tile_of(int L, int nM, int nN, int& pm, int& pn) {
    const int nwg = nM * nN; int wgid = L;
    { const int q = nwg / 8, r = nwg % 8, xcd = wgid % 8, off = wgid / 8; wgid = (xcd < r ? xcd * (q + 1) : r * (q + 1) + (xcd - r) * q) + off; }
    const int nig = 8 * nN, gid = wgid / nig, fm = gid * 8, gsz = (nM - fm) < 8 ? (nM - fm) : 8;
    pm = fm + ((wgid % nig) % gsz); pn = (wgid % nig) / gsz;
}

template <class Epi, class Sched>
__device__ __forceinline__ void gemm_phase(LAS unsigned char* lds, const Shape g, const Sched& S, const Epi& E, const int tid) {
    const int wid = __builtin_amdgcn_readfirstlane(tid >> 6), lane = tid & 63, wr = wid >> 2, wc = wid & 3, fr = lane & 15, fq = lane >> 4;
    const int K = g.K, nt = K / BK;
    unsigned voffA[2], voffB[2];
#pragma unroll
    for (int i = 0; i < 2; ++i) { int R, C; stage_rc(tid * 16 + i * 8192, R, C); const int Rb = Epi::PERM ? ((R & ~31) + perm32(R & 31)) : R;
        voffA[i] = (unsigned)(R * g.lda + C) * 2u; voffB[i] = (unsigned)(Rb * g.ldb + C) * 2u; }
    const size_t kstep = (size_t)(BK * 2);
    const size_t hstepA = (size_t)HALF * g.lda * 2, hstepB = (size_t)HALF * g.ldb * 2;
    const unsigned ldsw = (unsigned)wid * 1024u;
    const int aoff = lds_byte(wr * 64 + fr, fq * 8), boff = lds_byte(wc * 32 + fr, fq * 8);
#define PG8_SA(b, h) (((b) * 2 + (h)) * HTB)
#define PG8_SB(b, h) ((4 + (b) * 2 + (h)) * HTB)
#define PG8_STAGE(bufoff, gbase, voff) do { _Pragma("unroll") for (int _i = 0; _i < 2; ++_i) \
        __builtin_amdgcn_global_load_lds((const unsigned*)((const char*)(gbase) + (voff)[_i]), (LAS unsigned*)(lds + (bufoff) + ldsw + _i * 8192), 16, 0, 0); } while (0)
#define PG8_LDA(dst, b, h) do { _Pragma("unroll") for (int m = 0; m < 4; ++m) _Pragma("unroll") for (int k = 0; k < 2; ++k) dst[m][k] = *(const LAS bf16x8*)(lds + PG8_SA(b, h) + aoff + m * 2048 + k * 1024); } while (0)
#define PG8_LDB(dst, b, h) do { _Pragma("unroll") for (int n = 0; n < 2; ++n) _Pragma("unroll") for (int k = 0; k < 2; ++k) dst[n][k] = *(const LAS bf16x8*)(lds + PG8_SB(b, h) + boff + n * 2048 + k * 1024); } while (0)
#define PG8_MMA(ai, bj, At, Bt) do { __builtin_amdgcn_s_setprio(1); _Pragma("unroll") for (int m = 0; m < 4; ++m) _Pragma("unroll") for (int n = 0; n < 2; ++n) _Pragma("unroll") for (int k = 0; k < 2; ++k) \
        acc[ai][bj][m][n] = __builtin_amdgcn_mfma_f32_16x16x32_bf16(Bt[n][k], At[m][k], acc[ai][bj][m][n], 0, 0, 0); __builtin_amdgcn_s_setprio(0); } while (0)
#define PG8_WAIT_V(n) asm volatile("s_waitcnt vmcnt(" #n ")" ::: "memory")
#define PG8_WAIT_L(n) asm volatile("s_waitcnt lgkmcnt(" #n ")" ::: "memory")
#define PG8_BAR __builtin_amdgcn_s_barrier()
#define PG8_SCHED __builtin_amdgcn_sched_barrier(0)
    Unit cur, nxt; int ui = 0;
    if (!S.next(0, cur)) return;
    f32x4 acc[2][2][4][2];
#pragma unroll
    for (int a = 0; a < 2; ++a)
#pragma unroll
        for (int b = 0; b < 2; ++b)
#pragma unroll
            for (int m = 0; m < 4; ++m)
#pragma unroll
                for (int n = 0; n < 2; ++n) acc[a][b][m][n] = (f32x4){0.f, 0.f, 0.f, 0.f};
    bf16x8 At[4][2], B0[2][2], B1[2][2];
    const char* cA = cur.A; const char* cB = cur.B;
    PG8_STAGE(PG8_SB(0, 0), cB, voffB); PG8_STAGE(PG8_SB(0, 1), cB + hstepB, voffB); PG8_STAGE(PG8_SA(0, 0), cA, voffA); PG8_STAGE(PG8_SA(0, 1), cA + hstepA, voffA);
    if (wr == 1) PG8_BAR;
    PG8_WAIT_V(2); PG8_BAR;
    PG8_STAGE(PG8_SB(1, 0), cB + kstep, voffB); PG8_STAGE(PG8_SA(1, 0), cA + kstep, voffA); PG8_STAGE(PG8_SB(1, 1), cB + hstepB + kstep, voffB);
    PG8_WAIT_V(6); PG8_BAR;
    for (;;) {
        const bool has_next = S.next(ui + 1, nxt);
        const char* nA = has_next ? nxt.A : cA; const char* nB = has_next ? nxt.B : cB;
        for (int t = 0; t < nt; t += 2) {
            const bool last = (t == nt - 2);
            const char* a1 = cA + (size_t)(t + 1) * kstep;
            const char* a2 = last ? nA : cA + (size_t)(t + 2) * kstep; const char* b2 = last ? nB : cB + (size_t)(t + 2) * kstep;
            const char* a3 = a2 + kstep; const char* b3 = b2 + kstep;
            PG8_LDB(B0, 0, 0); PG8_LDB(B1, 0, 1); PG8_SCHED; PG8_LDA(At, 0, 0); PG8_STAGE(PG8_SA(1, 1), a1 + hstepA, voffA);
            PG8_WAIT_V(8); PG8_WAIT_L(0); PG8_BAR; PG8_MMA(0, 0, At, B0); PG8_MMA(0, 1, At, B1); PG8_BAR; PG8_SCHED;
            PG8_LDA(At, 0, 1); PG8_STAGE(PG8_SB(0, 0), b2, voffB); PG8_STAGE(PG8_SB(0, 1), b2 + hstepB, voffB); PG8_STAGE(PG8_SA(0, 0), a2, voffA);
            PG8_WAIT_V(8); PG8_WAIT_L(0); PG8_BAR; PG8_MMA(1, 0, At, B0); PG8_MMA(1, 1, At, B1); PG8_BAR; PG8_SCHED;
            PG8_LDB(B0, 1, 0); PG8_LDB(B1, 1, 1); PG8_SCHED; PG8_LDA(At, 1, 0); PG8_STAGE(PG8_SA(0, 1), a2 + hstepA, voffA);
            PG8_WAIT_V(8); PG8_WAIT_L(0); PG8_BAR; PG8_MMA(0, 0, At, B0); PG8_MMA(0, 1, At, B1); PG8_BAR; PG8_SCHED;
            PG8_LDA(At, 1, 1); PG8_STAGE(PG8_SB(1, 0), b3, voffB); PG8_STAGE(PG8_SB(1, 1), b3 + hstepB, voffB); PG8_STAGE(PG8_SA(1, 0), a3, voffA);
            PG8_WAIT_V(8); PG8_WAIT_L(0); PG8_BAR; PG8_MMA(1, 0, At, B0); PG8_MMA(1, 1, At, B1); PG8_BAR; PG8_SCHED;
        }
        if (wr == 0) PG8_BAR;
        E(acc, cur, wr, wc, lds);
        if (!has_next) break;
#pragma unroll
        for (int a = 0; a < 2; ++a)
#pragma unroll
            for (int b = 0; b < 2; ++b)
#pragma unroll
                for (int m = 0; m < 4; ++m)
#pragma unroll
                    for (int n = 0; n < 2; ++n) acc[a][b][m][n] = (f32x4){0.f, 0.f, 0.f, 0.f};
        cur = nxt; cA = nA; cB = nB; ++ui;
        if (wr == 1) PG8_BAR;
    }
    PG8_WAIT_V(0);
    PG8_BAR;
#undef PG8_SA
#undef PG8_SB
#undef PG8_STAGE
#undef PG8_LDA
#undef PG8_LDB
#undef PG8_MMA
#undef PG8_WAIT_V
#undef PG8_WAIT_L
#undef PG8_SCHED
}

struct EpiBf16 {
    static constexpr bool PERM = true;
    bf16* O0; bf16* O1; int ldc; float scale;
    __device__ __forceinline__ void operator()(const f32x4 (&acc)[2][2][4][2], const Unit& u, int wr, int wc, LAS unsigned char*) const {
        const int lane = fresh_lane(), fr = lane & 15, fq = lane >> 4;
        bf16* O = u.aux ? O1 : O0;
        const int row0 = u.pm * BM + wr * 64 + fr, col0 = u.pn * BM + wc * 32 + 8 * fq;
#pragma unroll
        for (int ai = 0; ai < 2; ++ai)
#pragma unroll
            for (int m = 0; m < 4; ++m) { bf16* rowp = O + (size_t)(row0 + ai * HALF + m * 16) * ldc + col0;
#pragma unroll
                for (int bj = 0; bj < 2; ++bj) { const f32x4 v0 = acc[ai][bj][m][0] * scale, v1 = acc[ai][bj][m][1] * scale;
                    u32x4 w; w.x = pk2(v0[0], v0[1]); w.y = pk2(v0[2], v0[3]); w.z = pk2(v1[0], v1[1]); w.w = pk2(v1[2], v1[3]);
                    *(u32x4*)(rowp + bj * HALF) = w; } }
    }
};
struct EpiProj {
    static constexpr bool PERM = true;
    bf16* P1; bf16* P2;
    __device__ __forceinline__ void operator()(const f32x4 (&acc)[2][2][4][2], const Unit& u, int wr, int wc, LAS unsigned char*) const {
        const int lane = fresh_lane(), fr = lane & 15, fq = lane >> 4;
        const bool second = u.pn >= 10; bf16* O = second ? P2 : P1; const int ldc = second ? 1536 : 2560;
        const int row0 = u.pm * BM + wr * 64 + fr, col0 = (second ? u.pn - 10 : u.pn) * BM + wc * 32 + 8 * fq;
#pragma unroll
        for (int ai = 0; ai < 2; ++ai)
#pragma unroll
            for (int m = 0; m < 4; ++m) { bf16* rowp = O + (size_t)(row0 + ai * HALF + m * 16) * ldc + col0;
#pragma unroll
                for (int bj = 0; bj < 2; ++bj) { const f32x4 v0 = acc[ai][bj][m][0], v1 = acc[ai][bj][m][1];
                    u32x4 w; w.x = pk2(v0[0], v0[1]); w.y = pk2(v0[2], v0[3]); w.z = pk2(v1[0], v1[1]); w.w = pk2(v1[2], v1[3]);
                    *(u32x4*)(rowp + bj * HALF) = w; } }
    }
};
struct EpiSwiGLU {
    static constexpr bool PERM = true;
    bf16* H;
    __device__ __forceinline__ void operator()(const f32x4 (&acc)[2][2][4][2], const Unit& u, int wr, int wc, LAS unsigned char*) const {
        const int lane = fresh_lane(), fr = lane & 15, fq = lane >> 4;
        const int row0 = u.pm * BM + wr * 64 + fr, col0 = u.pn * HALF + wc * 32 + 8 * fq;
#pragma unroll
        for (int ai = 0; ai < 2; ++ai)
#pragma unroll
            for (int m = 0; m < 4; ++m) { bf16* rowp = H + (size_t)(row0 + ai * HALF + m * 16) * DEXP + col0;
                float h[8];
#pragma unroll
                for (int n = 0; n < 2; ++n)
#pragma unroll
                    for (int j = 0; j < 4; ++j) { const float gt = acc[ai][0][m][n][j], up = acc[ai][1][m][n][j]; h[n * 4 + j] = gt * sigmoidf_(gt) * up; }
                u32x4 w; w.x = pk2(h[0], h[1]); w.y = pk2(h[2], h[3]); w.z = pk2(h[4], h[5]); w.w = pk2(h[6], h[7]);
                *(u32x4*)rowp = w; }
    }
};
struct EpiSoftmax {
    static constexpr bool PERM = true;
    bf16* P;
    __device__ __forceinline__ void operator()(f32x4 (&acc)[2][2][4][2], const Unit& u, int wr, int wc, LAS unsigned char* lds) const {
        const int lane = fresh_lane(), fr = lane & 15, fq = lane >> 4;
        LAS float* PM = (LAS float*)(lds + EPI_OFF);
        LAS float* PS = (LAS float*)(lds + EPI_OFF + 4096);
        float mx[2][4];
#pragma unroll
        for (int ai = 0; ai < 2; ++ai)
#pragma unroll
            for (int m = 0; m < 4; ++m) { float v = -3.0e38f;
#pragma unroll
                for (int bj = 0; bj < 2; ++bj)
#pragma unroll
                    for (int n = 0; n < 2; ++n)
#pragma unroll
                        for (int j = 0; j < 4; ++j) v = fmaxf(v, acc[ai][bj][m][n][j]);
                v = fmaxf(v, shx(v, 16, lane)); v = fmaxf(v, shx(v, 32, lane));
                if (fq == 0) PM[(ai * HALF + wr * 64 + m * 16 + fr) * 4 + wc] = v; }
        LDS_WAIT(); __builtin_amdgcn_s_barrier(); asm volatile("" ::: "memory");
#pragma unroll
        for (int ai = 0; ai < 2; ++ai)
#pragma unroll
            for (int m = 0; m < 4; ++m) { const f32x4 pm4 = *(const LAS f32x4*)(PM + (ai * HALF + wr * 64 + m * 16 + fr) * 4);
                const float rm = fmaxf(fmaxf(pm4[0], pm4[1]), fmaxf(pm4[2], pm4[3])); float s = 0.f;
#pragma unroll
                for (int bj = 0; bj < 2; ++bj)
#pragma unroll
                    for (int n = 0; n < 2; ++n)
#pragma unroll
                        for (int j = 0; j < 4; ++j) { const float ev = __expf(acc[ai][bj][m][n][j] - rm); acc[ai][bj][m][n][j] = ev; s += ev; }
                s += shx(s, 16, lane); s += shx(s, 32, lane);
                if (fq == 0) PS[(ai * HALF + wr * 64 + m * 16 + fr) * 4 + wc] = s; }
        LDS_WAIT(); __builtin_amdgcn_s_barrier(); asm volatile("" ::: "memory");
        const int row0 = u.pm * BM + wr * 64 + fr, col0 = u.pn * BM + wc * 32 + 8 * fq;
#pragma unroll
        for (int ai = 0; ai < 2; ++ai)
#pragma unroll
            for (int m = 0; m < 4; ++m) { const f32x4 ps4 = *(const LAS f32x4*)(PS + (ai * HALF + wr * 64 + m * 16 + fr) * 4);
                const float inv = 1.0f / ((ps4[0] + ps4[1]) + (ps4[2] + ps4[3]));
                bf16* rowp = P + (size_t)(row0 + ai * HALF + m * 16) * D + col0;
#pragma unroll
                for (int bj = 0; bj < 2; ++bj) { const f32x4 v0 = acc[ai][bj][m][0] * inv, v1 = acc[ai][bj][m][1] * inv; u32x4 w;
                    w.x = pk2(v0[0], v0[1]); w.y = pk2(v0[2], v0[3]); w.z = pk2(v1[0], v1[1]); w.w = pk2(v1[2], v1[3]);
                    *(u32x4*)(rowp + bj * HALF) = w; } }
    }
};
}

#define XB_TMO      128
#define XB_XCNT(j)  (256  + 64 * (j))
#define XB_XSUB(j)  (1280 + 64 * (j))
#define XB_XGEN(j)  (2304 + 64 * (j))
#define XB_TOP      3328
#define XB_TOPGEN   3392
#define XCD_BAR_WORDS 3456
#define XB_SPIN_CAP (1u << 22)
__device__ __forceinline__ unsigned xb_ld(unsigned* p)              { return __hip_atomic_load(p, __ATOMIC_RELAXED, __HIP_MEMORY_SCOPE_AGENT); }
__device__ __forceinline__ unsigned xb_add(unsigned* p, unsigned v) { return __hip_atomic_fetch_add(p, v, __ATOMIC_RELAXED, __HIP_MEMORY_SCOPE_AGENT); }
__device__ __forceinline__ unsigned xb_xcc_id() { return (unsigned)__builtin_amdgcn_s_getreg((3 << 11) | 20) & 0xFu; }
#define XB_SPIN(cond, bar) do { unsigned _sp = 0; while (cond) { __builtin_amdgcn_s_sleep(1); \
    if ((++_sp & 255u) == 0u) { if (xb_ld(&(bar)[XB_TMO])) break; if (_sp > XB_SPIN_CAP) { atomicAdd(&(bar)[XB_TMO], 1u); break; } } } } while (0)
struct XcdBarrier { unsigned* bar; unsigned x; volatile LAS unsigned* st; };
__device__ __forceinline__ XcdBarrier xcd_barrier_post(unsigned* bar, volatile LAS unsigned* st, int tid) {
    XcdBarrier b; b.bar = bar; b.x = xb_xcc_id(); b.st = st;
    if (tid == 0) (void)xb_add(&bar[XB_XCNT(b.x)], 1u);
    return b;
}
__device__ __forceinline__ void xcd_barrier_complete(unsigned* bar, unsigned x, unsigned& nloc, unsigned& nx) {
    const unsigned G = gridDim.x * gridDim.y * gridDim.z;
    unsigned sum, cnt, mine, sp = 0u;
    for (;;) {
        sum = 0u; cnt = 0u; mine = 0u;
#pragma unroll
        for (unsigned j = 0; j < 16; ++j) { const unsigned c = xb_ld(&bar[XB_XCNT(j)]); sum += c; cnt += (c > 0u) ? 1u : 0u; mine = (j == x) ? c : mine; }
        if (sum == G) break;
        __builtin_amdgcn_s_sleep(1);
        if ((++sp & 255u) == 0u) { if (xb_ld(&bar[XB_TMO])) break; if (sp > XB_SPIN_CAP) { atomicAdd(&bar[XB_TMO], 1u); break; } }
    }
    nloc = mine > 0u ? mine : 1u; nx = cnt > 0u ? cnt : 1u;
}
__device__ __forceinline__ void xcd_barrier(const XcdBarrier& b, int tid) {
    asm volatile("s_waitcnt vmcnt(0)" ::: "memory");
    __syncthreads();
    if (tid == 0) {
        unsigned* bar = b.bar;
        __builtin_amdgcn_s_waitcnt(0);
        unsigned nloc = b.st[0], nx = b.st[1];
        if (nloc == 0u) { xcd_barrier_complete(bar, b.x, nloc, nx); b.st[0] = nloc; b.st[1] = nx; }
        const unsigned old = xb_add(&bar[XB_XSUB(b.x)], 1u);
        const unsigned gen = old / nloc;
        if (old + 1u == (gen + 1u) * nloc) {
            __builtin_amdgcn_fence(__ATOMIC_RELEASE, "agent");
            asm volatile("s_waitcnt vmcnt(0)" ::: "memory");
            const unsigned og = xb_add(&bar[XB_TOP], 1u);
            const unsigned tg = og / nx;
            if (og + 1u == (tg + 1u) * nx) xb_add(&bar[XB_TOPGEN], 1u);
            else XB_SPIN(xb_ld(&bar[XB_TOPGEN]) == tg, bar);
            __builtin_amdgcn_fence(__ATOMIC_ACQUIRE, "agent");
            xb_add(&bar[XB_XGEN(b.x)], 1u);
            asm volatile("s_waitcnt vmcnt(0)" ::: "memory");
        } else {
            XB_SPIN(xb_ld(&bar[XB_XGEN(b.x)]) == gen, bar);
            __builtin_amdgcn_fence(__ATOMIC_ACQUIRE, "agent");
            asm volatile("s_waitcnt vmcnt(0)" ::: "memory");
        }
    }
    __syncthreads();
}

struct Params { const float* in[25]; float* out; unsigned char* ws; int ph_lo, ph_hi; };
enum { I_X = 0, I_MEM, I_WIN, I_LBL, I_HGNW, I_CONVW, I_ALOG, I_DTB, I_GDNW, I_WOUT, I_MLNG, I_MLNB, I_WMQ, I_WMK, I_WMV, I_WMO, I_WGRP, I_BGRP, I_WRT, I_BRT, I_WGATE, I_WUP, I_WDOWN, I_LNG, I_LNB };
constexpr int PH_PRO = 0, PH_KV = 1, PH_L0 = 2, PH_PER_LAYER = 16, N_PHASES = PH_L0 + DEPTH * PH_PER_LAYER;

struct Ctx { LAS unsigned char* lds; unsigned char* ws; const Params* p; int tid, lane, wave, gw, ngw, G, bid; };

__device__ __forceinline__ void transpose_item(const float* W, int ldw, int src_col0, int K, bf16* WT, int dst_row0, LAS float* scr, int k0, int lane) {
#pragma unroll 8
    for (int i = 0; i < 32; ++i) { const int kk = 2 * i + (lane >> 5); scr[kk * 33 + (lane & 31)] = W[(size_t)(k0 + kk) * ldw + src_col0 + (lane & 31)]; }
    LDS_WAIT(); asm volatile("" ::: "memory");
    const int c = lane & 7;
#pragma unroll
    for (int j = 0; j < 4; ++j) { const int n = (lane >> 3) + 8 * j; const LAS float* s = scr + (8 * c) * 33 + n;
        u32x4 o; o.x = pk2(s[0 * 33], s[1 * 33]); o.y = pk2(s[2 * 33], s[3 * 33]); o.z = pk2(s[4 * 33], s[5 * 33]); o.w = pk2(s[6 * 33], s[7 * 33]);
        *(u32x4*)(WT + (size_t)(dst_row0 + n) * K + k0 + 8 * c) = o; }
    LDS_WAIT(); asm volatile("" ::: "memory");
}

__device__ __forceinline__ void phase_prologue(const Ctx& C) {
    const Params& p = *C.p; unsigned char* ws = C.ws;
    LAS float* scr = (LAS float*)(C.lds + C.wave * 16384);
    constexpr int IT_WIN = DEPTH * 16 * 128, IT_SQ = DEPTH * 16 * 32;
    constexpr int NIT = IT_WIN + 5 * IT_SQ;
    for (int it = C.gw; it < NIT; it += C.ngw) {
        int r = it;
        if (r < IT_WIN) { const int l = r / (16 * 128), q = r % (16 * 128), kb = q / 128, nb = q % 128; const int n0 = nb * 32, src = n0 < 2048 ? n0 : (n0 < 2560 ? n0 + 1544 : n0 - 512);
            transpose_item(p.in[I_WIN] + (size_t)l * D * INW, INW, src, D, (bf16*)(ws + WS_W_IN) + (size_t)l * PW * D, n0, scr, kb * 64, C.lane); continue; }
        r -= IT_WIN;
        const int mat = r / IT_SQ, q2 = r % IT_SQ, l = q2 / 512, q = q2 % 512, kb = q / 32, nb = q % 32;
        const float* src; bf16* dst;
        if (mat == 0) { src = p.in[I_WOUT]; dst = (bf16*)(ws + WS_W_OUT); } else if (mat == 1) { src = p.in[I_WMQ]; dst = (bf16*)(ws + WS_W_Q); }
        else if (mat == 2) { src = p.in[I_WMO]; dst = (bf16*)(ws + WS_W_O); } else if (mat == 3) { src = p.in[I_WMK]; dst = (bf16*)(ws + WS_W_K); }
        else { src = p.in[I_WMV]; dst = (bf16*)(ws + WS_W_V); }
        transpose_item(src + (size_t)l * D * D, D, nb * 32, D, dst + (size_t)l * D * D, nb * 32, scr, kb * 64, C.lane);
    }
    for (int m = C.gw; m < NTOK; m += C.ngw) {
        const f32x4* xr = (const f32x4*)(p.in[I_X] + (size_t)m * D) + C.lane; f32x4* xo = (f32x4*)((float*)(ws + WS_X) + (size_t)m * D) + C.lane;
        u32x2* xb = (u32x2*)((bf16*)(ws + WS_XN) + (size_t)m * D) + C.lane;
#pragma unroll
        for (int j = 0; j < 4; ++j) { const f32x4 v = xr[64 * j]; xo[64 * j] = v; u32x2 w; w.x = pk2(v[0], v[1]); w.y = pk2(v[2], v[3]); xb[64 * j] = w; }
    }
    for (int m = C.gw; m < NMEM; m += C.ngw) {
        const f32x4* xr = (const f32x4*)(p.in[I_MEM] + (size_t)m * D) + C.lane; f32x4 v[4]; float s = 0.f;
#pragma unroll
        for (int j = 0; j < 4; ++j) { v[j] = xr[64 * j]; s += (v[j][0] + v[j][1]) + (v[j][2] + v[j][3]); }
        const float mean = wave_sum(s, C.lane) * (1.f / D); float s2 = 0.f;
#pragma unroll
        for (int j = 0; j < 4; ++j) { v[j] = v[j] - mean; s2 += (v[j][0] * v[j][0] + v[j][1] * v[j][1]) + (v[j][2] * v[j][2] + v[j][3] * v[j][3]); }
        const float rstd = 1.0f / sqrtf(wave_sum(s2, C.lane) * (1.f / D) + LN_EPS);
        u32x2* xb = (u32x2*)((bf16*)(ws + WS_MEMN) + (size_t)m * D) + C.lane;
#pragma unroll
        for (int j = 0; j < 4; ++j) { const f32x4 g = ((const f32x4*)p.in[I_MLNG])[C.lane + 64 * j], b = ((const f32x4*)p.in[I_MLNB])[C.lane + 64 * j]; const f32x4 y = v[j] * rstd * g + b;
            u32x2 w; w.x = pk2(y[0], y[1]); w.y = pk2(y[2], y[3]); xb[64 * j] = w; }
    }
    { float* wab = (float*)(ws + WS_SMALL + SM_WAB);
      for (int i = C.bid * 512 + C.tid; i < DEPTH * 8 * D; i += C.G * 512) { const int l = i / (8 * D), j = (i / D) % 8, k = i % D; wab[i] = p.in[I_WIN][(size_t)l * D * INW + (size_t)k * INW + 3584 + j]; } }
    { float* lb = (float*)(ws + WS_SMALL + SM_LB);
      for (int c = C.bid * 512 + C.tid; c < 512; c += C.G * 512) { float z[DEPTH], mx = -3e38f; for (int l = 0; l < DEPTH; ++l) { z[l] = p.in[I_LBL][l * 512 + c]; mx = fmaxf(mx, z[l]); }
          float s = 0.f; for (int l = 0; l < DEPTH; ++l) { z[l] = expf(z[l] - mx); s += z[l]; }
          float cum = 0.f; for (int l = 0; l < DEPTH; ++l) { if (l > 0) cum += z[l] / s; lb[l * 512 + c] = cum; } } }
}

__device__ __forceinline__ void convert_experts(const Ctx& C, int l) {
    const Params& p = *C.p; LAS float* scr = (LAS float*)(C.lds + C.wave * 16384);
    constexpr int IT_G = NEXP * 16 * 16, IT_D = NEXP * 8 * 32;
    for (int it = C.gw; it < 2 * IT_G + IT_D; it += C.ngw) {
        if (it < 2 * IT_G) { const int s = it / IT_G, r = it % IT_G, e = r / 256, q = r % 256, kb = q / 16, nb = q % 16, n0 = nb * 32;
            const float* src = p.in[s ? I_WUP : I_WGATE] + ((size_t)l * NEXP + e) * D * DEXP;
            transpose_item(src, DEXP, n0, D, (bf16*)(C.ws + WS_GU) + (size_t)e * D * D, 256 * (n0 >> 7) + 128 * s + (n0 & 127), scr, kb * 64, C.lane); }
        else { const int r = it - 2 * IT_G, e = r / 256, q = r % 256, kb = q / 32, nb = q % 32;
            transpose_item(p.in[I_WDOWN] + ((size_t)l * NEXP + e) * DEXP * D, D, nb * 32, DEXP, (bf16*)(C.ws + WS_DN) + (size_t)e * D * DEXP, nb * 32, scr, kb * 64, C.lane); }
    }
}

struct SchedDense {
    const char* A; const char* B; int nM, nN, lda, ldb, G, c;
    __device__ __forceinline__ bool next(int i, pg8::Unit& u) const {
        const long L = (long)i * G + c; if (L >= (long)nM * nN) return false;
        int pm, pn; pg8::tile_of((int)L, nM, nN, pm, pn);
        u.pm = pm; u.pn = pn; u.aux = 0; u.A = A + (size_t)pm * 256 * lda * 2; u.B = B + (size_t)pn * 256 * ldb * 2; return true; }
};
struct SchedKV {
    const char* memn; const char* wk; const char* wv; int G, c;
    __device__ __forceinline__ bool next(int i, pg8::Unit& u) const {
        const long L = (long)i * G + c; if (L >= 512) return false;
        const int which = (int)L >> 8; int pm, pn; pg8::tile_of((int)L & 255, 16, 16, pm, pn);
        u.pm = pm; u.pn = pn; u.aux = which;
        u.A = (which ? wv : memn) + (size_t)pm * 256 * D * 2; u.B = (which ? memn : wk) + (size_t)pn * 256 * D * 2; return true; }
};
struct SchedAttn {
    const char* A; const char* B; int pv, l, G, c;
    __device__ __forceinline__ bool next(int i, pg8::Unit& u) const {
        const long L = (long)i * G + c; if (L >= 512) return false;
        const int pm = (int)L >> 2, h = (int)L & 3, b = pm >> 3;
        u.pm = pm; u.pn = h; u.aux = 0; u.A = A + ((size_t)pm * 256 * D + h * 256) * 2;
        u.B = pv ? B + (((size_t)l * D + h * 256) * 4096 + b * 256) * 2 : B + ((size_t)b * 256 * 4096 + l * D + h * 256) * 2; return true; }
};
struct SchedMoE {
    const char* A; const char* B; const int* tile_tab; int ntiles, lda, ldb, G, c;
    __device__ __forceinline__ bool next(int i, pg8::Unit& u) const {
        const long L = (long)i * G + c; if (L >= (long)ntiles * 4) return false;
        int pm, pn; pg8::tile_of((int)L, ntiles, 4, pm, pn); const int e = __builtin_amdgcn_readfirstlane(tile_tab[16 + pm]);
        u.pm = pm; u.pn = pn; u.aux = 0; u.A = A + (size_t)pm * 256 * lda * 2; u.B = B + ((size_t)e * 1024 + pn * 256) * ldb * 2; return true; }
};

__device__ __forceinline__ void phase_prep(const Ctx& C, int l) {
    const Params& p = *C.p; unsigned char* ws = C.ws;
    const bf16* PROJ = (const bf16*)(ws + WS_PROJ2); const bf16* XN = (const bf16*)(ws + WS_XN);
    const float* convw = p.in[I_CONVW] + (size_t)l * 4 * 1536;
    for (int item = C.bid; item < NB * 32; item += C.G) {
        const int b = item >> 5, c = item & 31, t0 = c * 64; const size_t tokb = (size_t)b * T + t0;
        for (int cb = C.wave; cb < 12; cb += 8) {
            const int type = cb >> 2, h = cb & 3, cc = type * 512 + h * 128 + 2 * C.lane;
            float w[4][2];
#pragma unroll
            for (int k = 0; k < 4; ++k) { w[k][0] = convw[k * 1536 + cc]; w[k][1] = convw[k * 1536 + cc + 1]; }
            float xm[3][2];
#pragma unroll
            for (int k = 0; k < 3; ++k) { if (t0 == 0) { xm[k][0] = 0.f; xm[k][1] = 0.f; } else { const unsigned v = *(const unsigned*)(PROJ + (tokb - 3 + k) * P2W + cc); xm[k][0] = bflo(v); xm[k][1] = bfhi(v); } }
            bf16* dst = (bf16*)(ws + (type == 0 ? WS_QC : type == 1 ? WS_KC : WS_VC)) + h * 128 + 2 * C.lane;
            for (int t = 0; t < 64; ++t) {
                const unsigned v = *(const unsigned*)(PROJ + (tokb + t) * P2W + cc); const float c0 = bflo(v), c1 = bfhi(v);
                float y0 = w[0][0] * xm[0][0] + w[1][0] * xm[1][0] + w[2][0] * xm[2][0] + w[3][0] * c0;
                float y1 = w[0][1] * xm[0][1] + w[1][1] * xm[1][1] + w[2][1] * xm[2][1] + w[3][1] * c1;
                xm[0][0] = xm[1][0]; xm[0][1] = xm[1][1]; xm[1][0] = xm[2][0]; xm[1][1] = xm[2][1]; xm[2][0] = c0; xm[2][1] = c1;
                y0 = y0 * sigmoidf_(y0); y1 = y1 * sigmoidf_(y1);
                if (type < 2) { const float ss = wave_sum(y0 * y0 + y1 * y1, C.lane); float rn = 1.0f / sqrtf(ss + L2_EPS); if (type == 0) rn *= 0.08838834764831845f; y0 *= rn; y1 *= rn; }
                *(unsigned*)(dst + (tokb + t) * 512) = pk2(y0, y1);
            }
        }
        const float* wab = (const float*)(ws + WS_SMALL + SM_WAB) + (size_t)l * 8 * D;
        for (int tt = 0; tt < 8; ++tt) {
            const size_t tok = tokb + C.wave * 8 + tt; float xv[16];
#pragma unroll
            for (int j = 0; j < 4; ++j) { const u32x2 v = ((const u32x2*)(XN + tok * D))[C.lane + 64 * j]; xv[4 * j] = bflo(v.x); xv[4 * j + 1] = bfhi(v.x); xv[4 * j + 2] = bflo(v.y); xv[4 * j + 3] = bfhi(v.y); }
            float dots[8];
#pragma unroll
            for (int o = 0; o < 8; ++o) { float s = 0.f;
#pragma unroll
                for (int j = 0; j < 4; ++j) { const f32x4 wv = ((const f32x4*)(wab + o * D))[C.lane + 64 * j]; s += xv[4 * j] * wv[0] + xv[4 * j + 1] * wv[1] + xv[4 * j + 2] * wv[2] + xv[4 * j + 3] * wv[3]; }
                dots[o] = wave_sum(s, C.lane); }
            if (C.lane < 4) { const int h = C.lane; float ga = 0.f, gb = 0.f;
#pragma unroll
                for (int o = 0; o < 4; ++o) { ga = (h == o) ? dots[o] : ga; gb = (h == o) ? dots[4 + o] : gb; }
                const float z = ga + p.in[I_DTB][l * 4 + h]; const float sp = fmaxf(z, 0.f) + log1pf(expf(-fabsf(z)));
                ((float*)(ws + WS_G))[tok * 4 + h] = -expf(p.in[I_ALOG][l * 4 + h]) * sp;
                ((float*)(ws + WS_G + G_BETA))[tok * 4 + h] = 1.0f / (1.0f + expf(-gb)); }
        }
    }
}

template <int SKIP_HG, int SKIP_GD>
__device__ __forceinline__ void phase_rec_naive(const Ctx& C, int l) {
    const Params& p = *C.p; unsigned char* ws = C.ws;
    const bf16* PROJ = (const bf16*)(ws + WS_PROJ1); bf16* Y = (bf16*)(ws + WS_Y);
    LAS float* qs = (LAS float*)C.lds; LAS float* ks = qs + 2048; LAS float* fs = ks + 2048; LAS float* vs = fs + 2048;
    LAS float* op = vs + 2048;
    LAS float* os = op + 8192;
    LAS float* rp = os + 2048;
    LAS float* gs = rp + 1024;
    const int v = C.tid & 127, dq = C.tid >> 7;
    for (int item = C.bid; item < NB * 8; item += C.G) {
        const int b = item >> 3, h8 = item & 7, gd = h8 >> 2, h = h8 & 3;
        if ((gd && SKIP_GD) || (!gd && SKIP_HG)) continue;
        float S[32];
#pragma unroll
        for (int i = 0; i < 32; ++i) S[i] = 0.f;
        const float* lbp = (const float*)(ws + WS_SMALL + SM_LB) + l * 512 + h * 128;
        const float nw0 = p.in[gd ? I_GDNW : I_HGNW][l * 128 + C.lane], nw1 = p.in[gd ? I_GDNW : I_HGNW][l * 128 + C.lane + 64];
        for (int tb = 0; tb < T / 16; ++tb) {
            const size_t tok0 = (size_t)b * T + tb * 16;
#pragma unroll
            for (int i = 0; i < 4; ++i) { const int idx = C.tid + 512 * i, t = idx >> 7, d = idx & 127; const size_t tok = tok0 + t;
                if (!gd) { const float q = bf2f(PROJ[tok * P1W + C_HQ + h * 128 + d]), z = bf2f(PROJ[tok * P1W + C_HF + h * 128 + d]), vi = bf2f(PROJ[tok * P1W + C_HI + h * 128 + d]);
                    const float lb = lbp[d], sg = sigmoidf_(z); qs[idx] = q; fs[idx] = lb + (1.f - lb) * sg; ks[idx] = (1.f - lb) * (1.f - sg); vs[idx] = vi; }
                else { qs[idx] = bf2f(((const bf16*)(ws + WS_QC))[tok * 512 + h * 128 + d]); ks[idx] = bf2f(((const bf16*)(ws + WS_KC))[tok * 512 + h * 128 + d]); vs[idx] = bf2f(((const bf16*)(ws + WS_VC))[tok * 512 + h * 128 + d]); } }
            if (gd && C.tid < 16) { gs[C.tid] = ((const float*)(ws + WS_G))[(tok0 + C.tid) * 4 + h]; gs[16 + C.tid] = ((const float*)(ws + WS_G + G_BETA))[(tok0 + C.tid) * 4 + h]; }
            __syncthreads();
            if (!gd) {
                for (int t = 0; t < 16; ++t) { const float vv = vs[t * 128 + v]; float po = 0.f;
#pragma unroll
                    for (int i = 0; i < 32; ++i) { const int d = dq * 32 + i; S[i] = fs[t * 128 + d] * S[i] + ks[t * 128 + d] * vv; po += qs[t * 128 + d] * S[i]; }
                    op[(t * 4 + dq) * 128 + v] = po; }
            } else {
                for (int t = 0; t < 16; ++t) { float pr = 0.f;
#pragma unroll
                    for (int i = 0; i < 32; ++i) pr += ks[t * 128 + dq * 32 + i] * S[i];
                    rp[((t & 1) * 4 + dq) * 128 + v] = pr;
                    __syncthreads();
                    const float r = (rp[((t & 1) * 4 + 0) * 128 + v] + rp[((t & 1) * 4 + 1) * 128 + v]) + (rp[((t & 1) * 4 + 2) * 128 + v] + rp[((t & 1) * 4 + 3) * 128 + v]);
                    const float a = __expf(gs[t]); const float delta = gs[16 + t] * (vs[t * 128 + v] - a * r); float po = 0.f;
#pragma unroll
                    for (int i = 0; i < 32; ++i) { const int d = dq * 32 + i; S[i] = a * S[i] + ks[t * 128 + d] * delta; po += qs[t * 128 + d] * S[i]; }
                    op[(t * 4 + dq) * 128 + v] = po; }
            }
            __syncthreads();
#pragma unroll
            for (int i = 0; i < 4; ++i) { const int idx = C.tid + 512 * i, t = idx >> 7, vv = idx & 127; os[idx] = (op[(t * 4 + 0) * 128 + vv] + op[(t * 4 + 1) * 128 + vv]) + (op[(t * 4 + 2) * 128 + vv] + op[(t * 4 + 3) * 128 + vv]); }
            __syncthreads();
#pragma unroll
            for (int tt = 0; tt < 2; ++tt) { const int t = 2 * C.wave + tt; const size_t tok = tok0 + t; const float o0 = os[t * 128 + C.lane], o1 = os[t * 128 + C.lane + 64];
                const float r = 1.0f / sqrtf(wave_sum(o0 * o0 + o1 * o1, C.lane) * (1.f / 128.f) + RMS_EPS);
                const int gcol = (gd ? C_GZ : C_HZ) + h * 128 + C.lane; const float z0 = bf2f(PROJ[tok * P1W + gcol]), z1 = bf2f(PROJ[tok * P1W + gcol + 64]);
                const float g0 = gd ? z0 * sigmoidf_(z0) : sigmoidf_(z0), g1 = gd ? z1 * sigmoidf_(z1) : sigmoidf_(z1);
                Y[tok * D + gd * 512 + h * 128 + C.lane] = (bf16)f2bf(o0 * r * nw0 * g0); Y[tok * D + gd * 512 + h * 128 + C.lane + 64] = (bf16)f2bf(o1 * r * nw1 * g1); }
        }
        __syncthreads();
    }
}


__device__ __forceinline__ int img_off(int r, int c, int KS) { const int rr = r & 15, pp = pg8::perm32(c & 31); return ((r >> 4) * KS + (c >> 5)) * 1024 + ((rr * 64 + pp * 2) ^ ((rr >> 3) << 5)); }
__device__ __forceinline__ int u_idx(int t, int v) { return (((v >> 4) * 64 + ((t & 15) >> 2) * 16 + (v & 15)) * 4 + (t >> 4)) * 4 + (t & 3); }
__device__ __forceinline__ f32x4 mfma16(bf16x8 a, bf16x8 b, f32x4 c) { return __builtin_amdgcn_mfma_f32_16x16x32_bf16(a, b, c, 0, 0, 0); }
constexpr int RP = 136;
__device__ __forceinline__ f32x4 score_tile(const LAS bf16* X, const LAS bf16* Y, int mt, int nt, int lane) {
    const int rr = lane & 15, g = lane >> 4; f32x4 acc = (f32x4){0.f, 0.f, 0.f, 0.f};
#pragma unroll
    for (int kk = 0; kk < 4; ++kk) { const bf16x8 a = *(const LAS bf16x8*)(X + (16 * mt + rr) * RP + 32 * kk + 8 * g), b = *(const LAS bf16x8*)(Y + (16 * nt + rr) * RP + 32 * kk + 8 * g); acc = mfma16(a, b, acc); }
    return acc;
}
__device__ __forceinline__ void copy_record(const Ctx& C, unsigned char* dst, int bytes) {
    for (int i = C.tid; i < bytes / 16; i += 512) ((u32x4*)dst)[i] = ((const LAS u32x4*)C.lds)[i];
}

__device__ __forceinline__ void r1_hgrn2(const Ctx& C, int l, int b, int h, int n) {
    constexpr int O_KT = 16384, O_QK = 32768, O_E = 40960, O_U = 41984;
    LAS unsigned char* L = C.lds; LAS bf16* Qs = (LAS bf16*)(L + 59392); LAS bf16* Ks = (LAS bf16*)(L + 59392 + 17408); LAS float* segt = (LAS float*)(L + 59392 + 2 * 17408);
    asm volatile("" : "+v"(Qs), "+v"(Ks), "+v"(segt), "+v"(L));
    const bf16* PROJ = (const bf16*)(C.ws + WS_PROJ1);
    const int d = C.tid & 127, seg = C.tid >> 7; const size_t tok0 = (size_t)b * T + n * 64;
    const float lb = ((const float*)(C.ws + WS_SMALL + SM_LB))[l * 512 + h * 128 + d];
    float run = 0.f;
    for (int i = 0; i < 16; ++i) { const int t = 16 * seg + i; const bf16* row = PROJ + (tok0 + t) * P1W + h * 128 + d;
        const float z = bf2f(row[C_HF]); const unsigned vb = row[C_HI];
        const float sg = 1.0f / (1.0f + __expf(-z)), f = lb + (1.f - lb) * sg; run += __logf(f);
        *(LAS bf16*)(L + O_U + 2 * u_idx(t, d)) = (bf16)vb; }
    segt[seg * 128 + d] = run;
    __syncthreads();
    const float s0 = segt[d], s1 = segt[128 + d], s2 = segt[256 + d], s3 = segt[384 + d];
    const float prefix = seg == 0 ? 0.f : seg == 1 ? s0 : seg == 2 ? s0 + s1 : (s0 + s1) + s2, ref = s0 + s1, last = (s0 + s1) + (s2 + s3);
    float c = prefix;
    for (int i = 0; i < 16; ++i) { const int t = 16 * seg + i; const bf16* row = PROJ + (tok0 + t) * P1W + h * 128 + d;
        const float qv = bf2f(row[C_HQ]), z = bf2f(row[C_HF]);
        const float sg = 1.0f / (1.0f + __expf(-z)), f = lb + (1.f - lb) * sg, kv = (1.f - lb) * (1.f - sg); c += __logf(f);
        Qs[t * RP + d] = (bf16)f2bf(qv * __expf(c - ref)); Ks[t * RP + d] = (bf16)f2bf(kv * __expf(ref - c));
        *(LAS bf16*)(L + img_off(t, d, 4)) = (bf16)f2bf(qv * __expf(c));
        *(LAS bf16*)(L + O_KT + img_off(d, t, 2)) = (bf16)f2bf(kv * __expf(last - c)); }
    if (seg == 0) *(LAS float*)(L + O_E + 4 * d) = __expf(last);
    if (seg == 1) *(LAS float*)(L + O_E + 512 + 4 * d) = 0.f;
    __syncthreads();
#pragma unroll
    for (int jj = 0; jj < 2; ++jj) { const int job = C.wave + 8 * jj, mt = job >> 2, nt = job & 3, rr = C.lane & 15, g = C.lane >> 4;
        f32x4 acc = (f32x4){0.f, 0.f, 0.f, 0.f};
        if (nt <= mt) acc = score_tile(Qs, Ks, mt, nt, C.lane);
#pragma unroll
        for (int r = 0; r < 4; ++r) { const int t = 16 * mt + 4 * g + r, sx = 16 * nt + rr; *(LAS bf16*)(L + O_QK + img_off(t, sx, 2)) = (bf16)f2bf((nt <= mt && sx <= t) ? acc[r] : 0.f); } }
    __syncthreads();
    copy_record(C, C.ws + WS_RECH + ((size_t)(b * 4 + h) * 32 + n) * REC_H, REC_H);
    __syncthreads();
}

template <int T0> struct SolveRows {
    static __device__ __forceinline__ void run(float (&X)[64], const LAS float* Am, const LAS bf16* Ks, const LAS bf16* Vs, const LAS float* bt, const LAS float* ec, LAS unsigned char* L, int col, bool isw) {
        constexpr int O_U = 58368;
        float a = isw ? bf2f(Ks[T0 * RP + col]) * bt[T0] * ec[T0] : bf2f(Vs[T0 * 128 + col]) * bt[T0];
#pragma unroll
        for (int s4 = 0; s4 < (T0 + 3) / 4; ++s4) { const f32x4 av = *(const LAS f32x4*)(Am + T0 * 64 + 4 * s4);
#pragma unroll
            for (int e = 0; e < 4; ++e) if (4 * s4 + e < T0) a -= av[e] * X[4 * s4 + e]; }
        X[T0] = a;
        if (isw) *(LAS bf16*)(L + img_off(64 + T0, col, 4)) = (bf16)f2bf(a); else *(LAS bf16*)(L + O_U + 2 * u_idx(T0, col)) = (bf16)f2bf(a);
        SolveRows<T0 + 1>::run(X, Am, Ks, Vs, bt, ec, L, col, isw);
    }
};
template <> struct SolveRows<64> { static __device__ __forceinline__ void run(float (&)[64], const LAS float*, const LAS bf16*, const LAS bf16*, const LAS float*, const LAS float*, LAS unsigned char*, int, bool) {} };

__device__ __forceinline__ void r1_gdn(const Ctx& C, int b, int h, int n) {
    constexpr int O_KT = 32768, O_QK = 49152, O_E = 57344, O_U = 58368, LQ = 75776, LK = LQ + 17408, LV = LK + 17408, LA = LV + 16384, LC = LA + 16384;
    LAS unsigned char* L = C.lds; LAS bf16* Qs = (LAS bf16*)(L + LQ); LAS bf16* Ks = (LAS bf16*)(L + LK); LAS bf16* Vs = (LAS bf16*)(L + LV); LAS float* Am = (LAS float*)(L + LA);
    LAS float* cs = (LAS float*)(L + LC);
    asm volatile("" : "+v"(Qs), "+v"(Ks), "+v"(Vs), "+v"(Am), "+v"(cs), "+v"(L));
    LAS float* ec = cs + 64; LAS float* bt = cs + 128;
    const size_t tok0 = (size_t)b * T + n * 64;
#pragma unroll
    for (int i = 0; i < 2; ++i) { const int idx = C.tid + 512 * i, t = idx >> 4, pc = idx & 15; const size_t go = (tok0 + t) * 512 + h * 128 + pc * 8;
        *(LAS u32x4*)(Qs + t * RP + pc * 8) = *(const u32x4*)((const bf16*)(C.ws + WS_QC) + go);
        *(LAS u32x4*)(Ks + t * RP + pc * 8) = *(const u32x4*)((const bf16*)(C.ws + WS_KC) + go);
        *(LAS u32x4*)(Vs + t * 128 + pc * 8) = *(const u32x4*)((const bf16*)(C.ws + WS_VC) + go); }
    { unsigned z0 = 0u; asm volatile("" : "+v"(z0)); ((LAS u32x4*)(L + O_QK))[C.tid] = (u32x4){z0, z0, z0, z0}; }
    if (C.wave == 0) { float c = ((const float*)(C.ws + WS_G))[(tok0 + C.lane) * 4 + h];
#pragma unroll
        for (int o = 1; o < 64; o <<= 1) { const float nb = shx(c, o, C.lane); const float up = __builtin_bit_cast(float, __builtin_amdgcn_ds_bpermute(((C.lane - o) & 63) << 2, __builtin_bit_cast(int, c))); (void)nb; if (C.lane >= o) c += up; }
        cs[C.lane] = c; ec[C.lane] = __expf(c); bt[C.lane] = ((const float*)(C.ws + WS_G + G_BETA))[(tok0 + C.lane) * 4 + h]; }
    __syncthreads();
    for (int job = C.wave; job < 20; job += 8) { const int ty = job >= 10, j10 = job - 10 * ty; int mt = j10 < 1 ? 0 : j10 < 3 ? 1 : j10 < 6 ? 2 : 3; const int nt = j10 - (mt * (mt + 1)) / 2;
        const f32x4 acc = score_tile(ty ? Qs : Ks, Ks, mt, nt, C.lane); const int rr = C.lane & 15, g = C.lane >> 4;
#pragma unroll
        for (int r = 0; r < 4; ++r) { const int t = 16 * mt + 4 * g + r, sx = 16 * nt + rr; const float dec = __expf(cs[t] - cs[sx]);
            if (ty) *(LAS bf16*)(L + O_QK + img_off(t, sx, 2)) = (bf16)f2bf(sx <= t ? acc[r] * dec : 0.f);
            else Am[t * 64 + sx] = sx < t ? bt[t] * acc[r] * dec : 0.f; } }
    __syncthreads();
    if (C.tid < 256) {
        const int j = C.tid, col = j & 127; const bool isw = j >= 128; float X[64];
        SolveRows<0>::run(X, Am, Ks, Vs, bt, ec, L, col, isw);
    } else {
        const int j = C.tid - 256; const float clast = cs[63];
        for (int idx = j; idx < 8192; idx += 256) { const int t = idx >> 7, dd = idx & 127;
            *(LAS bf16*)(L + img_off(t, dd, 4)) = (bf16)f2bf(bf2f(Qs[t * RP + dd]) * ec[t]);
            *(LAS bf16*)(L + O_KT + img_off(dd, t, 2)) = (bf16)f2bf(bf2f(Ks[t * RP + dd]) * __expf(clast - cs[t])); }
        *(LAS float*)(L + O_E + 4 * j) = j < 128 ? __expf(clast) : 0.f;
    }
    __syncthreads();
    copy_record(C, C.ws + WS_RECG + ((size_t)(b * 4 + h) * 32 + n) * REC_G, REC_G);
    __syncthreads();
}

template <int MODE>
__device__ __forceinline__ void phase_r1(const Ctx& C, int l) {
    for (int item = C.bid; item < 4096; item += C.G) {
        const int gd = item < 2048, r = item & 2047, b = r >> 7, h = (r >> 5) & 3, n = r & 31;
        if (gd) { if (MODE == 2) r1_gdn(C, b, h, n); } else r1_hgrn2(C, l, b, h, n);
    }
}

template <int MODE>
__device__ __forceinline__ void phase_r2(const Ctx& C, int l) {
    const Params& p = *C.p; unsigned char* ws = C.ws; LAS unsigned char* L = C.lds;
    constexpr int BUFB = 58368; LAS float* OS = (LAS float*)(L + 2 * BUFB);
    asm volatile("" : "+v"(OS));
    const bf16* PROJ = (const bf16*)(ws + WS_PROJ1); bf16* Y = (bf16*)(ws + WS_Y);
    const int rr = C.lane & 15, g = C.lane >> 4, w = C.wave;
    const int aoffl = (rr * 64 + g * 16) ^ ((rr >> 3) << 5);
    for (int item = C.bid; item < NB * 8; item += C.G) {
        const int b = item >> 3, h8 = item & 7, gd = h8 >> 2, h = h8 & 3;
        if (MODE == 1 && gd) continue;
        const unsigned char* rec0 = gd ? ws + WS_RECG + (size_t)(b * 4 + h) * 32 * REC_G : ws + WS_RECH + (size_t)(b * 4 + h) * 32 * REC_H;
        const int recsz = gd ? REC_G : REC_H, npc = gd ? 57 : 41, o_kt = gd ? 32768 : 16384, o_qk = gd ? 49152 : 32768, o_e = gd ? 57344 : 40960, o_u = gd ? 58368 : 41984;
        const float nw0 = p.in[gd ? I_GDNW : I_HGNW][l * 128 + 2 * C.lane], nw1 = p.in[gd ? I_GDNW : I_HGNW][l * 128 + 2 * C.lane + 1];
        f32x4 S[8];
#pragma unroll
        for (int i = 0; i < 8; ++i) S[i] = (f32x4){0.f, 0.f, 0.f, 0.f};
        __syncthreads();
        u32x4 un0 = *(const u32x4*)(rec0 + o_u + (w * 64 + C.lane) * 32), un1 = *(const u32x4*)(rec0 + o_u + (w * 64 + C.lane) * 32 + 16);
        for (int pc = w; pc < npc; pc += 8) __builtin_amdgcn_global_load_lds((const unsigned*)(rec0 + pc * 1024 + C.lane * 16), (LAS unsigned*)(L + pc * 1024), 16, 0, 0);
        for (int n = 0; n < 32; ++n) {
            LAS unsigned char* B = L + (n & 1) * BUFB; const size_t tok0 = (size_t)b * T + n * 64;
            const u32x4 uc0 = un0, uc1 = un1;
            VM_WAIT(); __builtin_amdgcn_s_barrier(); asm volatile("" ::: "memory");
            unsigned zg[8];
#pragma unroll
            for (int i = 0; i < 8; ++i) zg[i] = *(const unsigned*)(PROJ + (tok0 + 8 * w + i) * P1W + (gd ? C_GZ : C_HZ) + h * 128 + 2 * C.lane);
            if (n + 1 < 32) { const unsigned char* rn = rec0 + (size_t)(n + 1) * recsz;
                un0 = *(const u32x4*)(rn + o_u + (w * 64 + C.lane) * 32); un1 = *(const u32x4*)(rn + o_u + (w * 64 + C.lane) * 32 + 16);
                LAS unsigned char* Bn = L + ((n + 1) & 1) * BUFB;
                for (int pc = w; pc < npc; pc += 8) __builtin_amdgcn_global_load_lds((const unsigned*)(rn + pc * 1024 + C.lane * 16), (LAS unsigned*)(Bn + pc * 1024), 16, 0, 0); }
            bf16x8 sf[4];
#pragma unroll
            for (int kk = 0; kk < 4; ++kk) { u32x4 t4; t4.x = pk2(S[2 * kk][0], S[2 * kk][1]); t4.y = pk2(S[2 * kk][2], S[2 * kk][3]); t4.z = pk2(S[2 * kk + 1][0], S[2 * kk + 1][1]); t4.w = pk2(S[2 * kk + 1][2], S[2 * kk + 1][3]); sf[kk] = __builtin_bit_cast(bf16x8, t4); }
            f32x4 P[8];
#pragma unroll
            for (int m = 0; m < 8; ++m) { P[m] = (f32x4){0.f, 0.f, 0.f, 0.f};
                if (m < 4 || gd) {
#pragma unroll
                    for (int kk = 0; kk < 4; ++kk) P[m] = mfma16(*(const LAS bf16x8*)(B + (m * 4 + kk) * 1024 + aoffl), sf[kk], P[m]); } }
            f32x4 vn[4];
            { const unsigned uu[8] = {uc0.x, uc0.y, uc0.z, uc0.w, uc1.x, uc1.y, uc1.z, uc1.w};
#pragma unroll
              for (int m = 0; m < 4; ++m) vn[m] = (f32x4){bflo(uu[2 * m]), bfhi(uu[2 * m]), bflo(uu[2 * m + 1]), bfhi(uu[2 * m + 1])} - P[4 + m]; }
            bf16x8 vf[2];
#pragma unroll
            for (int kk = 0; kk < 2; ++kk) { u32x4 t4; t4.x = pk2(vn[2 * kk][0], vn[2 * kk][1]); t4.y = pk2(vn[2 * kk][2], vn[2 * kk][3]); t4.z = pk2(vn[2 * kk + 1][0], vn[2 * kk + 1][1]); t4.w = pk2(vn[2 * kk + 1][2], vn[2 * kk + 1][3]); vf[kk] = __builtin_bit_cast(bf16x8, t4); }
#pragma unroll
            for (int m = 0; m < 4; ++m)
#pragma unroll
                for (int kk = 0; kk < 2; ++kk) P[m] = mfma16(*(const LAS bf16x8*)(B + o_qk + (m * 2 + kk) * 1024 + aoffl), vf[kk], P[m]);
#pragma unroll
            for (int i = 0; i < 8; ++i) { const f32x4 ev = *(const LAS f32x4*)(B + o_e + (16 * i + 4 * g) * 4); S[i] = S[i] * ev;
#pragma unroll
                for (int kk = 0; kk < 2; ++kk) S[i] = mfma16(*(const LAS bf16x8*)(B + o_kt + (i * 2 + kk) * 1024 + aoffl), vf[kk], S[i]); }
#pragma unroll
            for (int m = 0; m < 4; ++m)
#pragma unroll
                for (int r = 0; r < 4; ++r) OS[(16 * m + 4 * g + r) * 132 + 16 * w + rr] = P[m][r];
            LDS_WAIT(); __builtin_amdgcn_s_barrier(); asm volatile("" ::: "memory");
#pragma unroll
            for (int i = 0; i < 8; ++i) { const int t = 8 * w + i; const f32x2 o2 = *(const LAS f32x2*)(OS + t * 132 + 2 * C.lane);
                const float r = 1.0f / sqrtf(wave_sum(o2.x * o2.x + o2.y * o2.y, C.lane) * (1.f / 128.f) + RMS_EPS);
                const float z0 = bflo(zg[i]), z1 = bfhi(zg[i]); const float g0 = gd ? z0 * sigmoidf_(z0) : sigmoidf_(z0), g1 = gd ? z1 * sigmoidf_(z1) : sigmoidf_(z1);
                *(unsigned*)(Y + (tok0 + t) * D + gd * 512 + h * 128 + 2 * C.lane) = pk2(o2.x * r * nw0 * g0, o2.y * r * nw1 * g1); }
        }
        VM_WAIT(); __syncthreads();
    }
}

template <int MODE>
__device__ __forceinline__ void phase_ln(const Ctx& C, int l, int which, bool last) {
    const Params& p = *C.p; unsigned char* ws = C.ws;
    const f32x4* gp = (const f32x4*)(p.in[I_LNG] + ((size_t)l * 3 + which) * D); const f32x4* bp = (const f32x4*)(p.in[I_LNB] + ((size_t)l * 3 + which) * D);
    f32x4 g[4], bb[4];
#pragma unroll
    for (int j = 0; j < 4; ++j) { g[j] = gp[C.lane + 64 * j]; bb[j] = bp[C.lane + 64 * j]; }
    for (int m = C.gw; m < NTOK; m += C.ngw) {
        f32x4* xr = (f32x4*)((float*)(ws + WS_X) + (size_t)m * D) + C.lane; f32x4 v[4]; float s = 0.f;
        const u32x2* f0; const u32x2* f1 = nullptr; float w0 = 1.f, w1 = 0.f;
        if (MODE == 0) f0 = (const u32x2*)((const bf16*)(ws + WS_F) + (size_t)m * D) + C.lane;
        else { const int d0 = ((const int*)(ws + WS_G + G_DEST))[2 * m], d1 = ((const int*)(ws + WS_G + G_DEST))[2 * m + 1]; w0 = ((const float*)(ws + WS_G + G_GATES))[2 * m]; w1 = ((const float*)(ws + WS_G + G_GATES))[2 * m + 1];
            f0 = (const u32x2*)((const bf16*)(ws + WS_BUF) + (size_t)d0 * D) + C.lane; f1 = (const u32x2*)((const bf16*)(ws + WS_BUF) + (size_t)d1 * D) + C.lane; }
#pragma unroll
        for (int j = 0; j < 4; ++j) { const f32x4 x = xr[64 * j]; const u32x2 a = f0[64 * j]; f32x4 f = (f32x4){bflo(a.x), bfhi(a.x), bflo(a.y), bfhi(a.y)};
            if (MODE == 1) { const u32x2 c = f1[64 * j]; f = f * w0 + (f32x4){bflo(c.x), bfhi(c.x), bflo(c.y), bfhi(c.y)} * w1; }
            v[j] = x * ALPHA + f; s += (v[j][0] + v[j][1]) + (v[j][2] + v[j][3]); }
        const float mean = wave_sum(s, C.lane) * (1.f / D); float s2 = 0.f;
#pragma unroll
        for (int j = 0; j < 4; ++j) { v[j] = v[j] - mean; s2 += (v[j][0] * v[j][0] + v[j][1] * v[j][1]) + (v[j][2] * v[j][2] + v[j][3] * v[j][3]); }
        const float rstd = 1.0f / sqrtf(wave_sum(s2, C.lane) * (1.f / D) + LN_EPS);
        u32x2* xb = (u32x2*)((bf16*)(ws + WS_XN) + (size_t)m * D) + C.lane; f32x4* xo = (f32x4*)(p.out + (size_t)m * D) + C.lane;
#pragma unroll
        for (int j = 0; j < 4; ++j) { const f32x4 y = v[j] * rstd * g[j] + bb[j]; xr[64 * j] = y; u32x2 w; w.x = pk2(y[0], y[1]); w.y = pk2(y[2], y[3]); xb[64 * j] = w; if (last) xo[64 * j] = y; }
    }
}

__device__ __forceinline__ void phase_route(const Ctx& C, int l) {
    const Params& p = *C.p; unsigned char* ws = C.ws;
    LAS float* xs = (LAS float*)C.lds;
    LAS float* wsh = xs + 128 * 65;
    LAS float* lg = wsh + 64 * 36;
    LAS int* es = (LAS int*)(lg + 128 * 36);
    LAS int* rk = es + 256;
    const float* X = (const float*)(ws + WS_X);
    const float* wg = p.in[I_WGRP] + (size_t)l * D * 4; const float* wr_ = p.in[I_WRT] + (size_t)l * D * 32;
    const int t = C.tid & 127, og = C.tid >> 7;
    for (int item = C.bid; item < 256; item += C.G) {
        const size_t tok0 = (size_t)item * 128;
        float acc[9];
#pragma unroll
        for (int i = 0; i < 9; ++i) acc[i] = 0.f;
        for (int k0 = 0; k0 < D; k0 += 64) {
            __syncthreads();
#pragma unroll
            for (int i = 0; i < 16; ++i) { const int idx = C.tid + 512 * i, r = idx >> 6, c = idx & 63; xs[r * 65 + c] = X[(tok0 + r) * D + k0 + c]; }
            for (int idx = C.tid; idx < 64 * 36; idx += 512) { const int k = idx / 36, o = idx % 36; wsh[idx] = o < 4 ? wg[(size_t)(k0 + k) * 4 + o] : wr_[(size_t)(k0 + k) * 32 + o - 4]; }
            __syncthreads();
#pragma unroll 8
            for (int k = 0; k < 64; ++k) { const float xv = xs[t * 65 + k];
#pragma unroll
                for (int i = 0; i < 9; ++i) acc[i] += xv * wsh[k * 36 + og * 9 + i]; }
        }
#pragma unroll
        for (int i = 0; i < 9; ++i) lg[t * 36 + og * 9 + i] = acc[i];
        __syncthreads();
        int e0 = 0, e1 = 0; float w0 = 0.f, w1 = 0.f;
        if (C.tid < 128) {
            float gl[4]; int gsel = 0;
#pragma unroll
            for (int j = 0; j < 4; ++j) gl[j] = lg[C.tid * 36 + j] + p.in[I_BGRP][l * 4 + j];
#pragma unroll
            for (int j = 1; j < 4; ++j) if (gl[j] > gl[gsel]) gsel = j;
            float gsum = 0.f;
#pragma unroll
            for (int j = 0; j < 4; ++j) gsum += expf(gl[j] - gl[gsel]);
            const float ggate = 1.0f / gsum;
            float el[8];
#pragma unroll
            for (int j = 0; j < 8; ++j) el[j] = lg[C.tid * 36 + 4 + gsel * 8 + j] + p.in[I_BRT][l * 32 + gsel * 8 + j];
            int t1 = 0;
#pragma unroll
            for (int j = 1; j < 8; ++j) if (el[j] > el[t1]) t1 = j;
            int t2 = (t1 == 0) ? 1 : 0;
#pragma unroll
            for (int j = 0; j < 8; ++j) if (j != t1 && el[j] > el[t2]) t2 = j;
            const float ex = expf(el[t2] - el[t1]); w0 = ggate / (1.f + ex); w1 = ggate * ex / (1.f + ex);
            e0 = gsel * 8 + t1; e1 = gsel * 8 + t2; es[2 * C.tid] = e0; es[2 * C.tid + 1] = e1;
        }
        __syncthreads();
        if (C.tid < 32) { int cnt = 0; for (int a = 0; a < 256; ++a) if (es[a] == C.tid) { rk[a] = cnt; ++cnt; } ((int*)(ws + WS_SMALL + SM_CNT))[item * 32 + C.tid] = cnt; }
        __syncthreads();
        if (C.tid < 128) { const size_t tok = tok0 + C.tid; int* ro = (int*)(ws + WS_G + G_ROUTE) + tok * 4; ro[0] = e0; ro[1] = e1; ro[2] = rk[2 * C.tid]; ro[3] = rk[2 * C.tid + 1];
            float* gt = (float*)(ws + WS_G + G_GATES) + tok * 2; gt[0] = w0; gt[1] = w1; }
    }
    __syncthreads();
}

__device__ __forceinline__ void phase_dispatch(const Ctx& C) {
    unsigned char* ws = C.ws;
    LAS int* cn = (LAS int*)C.lds;
    LAS int* tot = cn + 8192; LAS int* bef = tot + 32; LAS int* base = bef + 32; LAS int* pst = base + 32; LAS int* dl = pst + 32;
    const int* cnt_all = (const int*)(ws + WS_SMALL + SM_CNT);
    bf16* BUF = (bf16*)(ws + WS_BUF); const bf16* XN = (const bf16*)(ws + WS_XN);
    for (int item = C.bid; item < 256; item += C.G) {
        __syncthreads();
        for (int i = C.tid; i < 8192; i += 512) cn[i] = cnt_all[i];
        __syncthreads();
        if (C.tid < 32) { int s = 0, bsum = 0; for (int b = 0; b < 256; ++b) { const int c = cn[b * 32 + C.tid]; if (b < item) bsum += c; s += c; } tot[C.tid] = s; bef[C.tid] = bsum; }
        __syncthreads();
        if (C.tid == 0) { int ps = 0; for (int e = 0; e < 32; ++e) { pst[e] = ps; base[e] = ps + bef[e]; ps += (tot[e] + 255) & ~255; }
            if (item == 0) { int* tt = (int*)(ws + WS_SMALL + SM_TILE); tt[0] = ps >> 8; for (int e = 0; e < 32; ++e) for (int r = pst[e]; r < pst[e] + ((tot[e] + 255) & ~255); r += 256) tt[16 + (r >> 8)] = e; } }
        __syncthreads();
        if (C.tid < 128) { const size_t tok = (size_t)item * 128 + C.tid; const int* ro = (const int*)(ws + WS_G + G_ROUTE) + tok * 4; const int d0 = base[ro[0]] + ro[2], d1 = base[ro[1]] + ro[3];
            int* dd = (int*)(ws + WS_G + G_DEST) + tok * 2; dd[0] = d0; dd[1] = d1; dl[2 * C.tid] = d0; dl[2 * C.tid + 1] = d1; }
        __syncthreads();
        for (int a = C.wave; a < 256; a += 8) { const size_t tok = (size_t)item * 128 + (a >> 1); const u32x4* src = (const u32x4*)(XN + tok * D); u32x4* dst = (u32x4*)(BUF + (size_t)dl[a] * D);
            dst[C.lane] = src[C.lane]; dst[C.lane + 64] = src[C.lane + 64]; }
        if (item < 32) { const int e = item, r0 = pst[e] + tot[e], r1 = pst[e] + ((tot[e] + 255) & ~255);
            for (int r = r0 + C.wave; r < r1; r += 8) { u32x4* dst = (u32x4*)(BUF + (size_t)r * D); dst[C.lane] = (u32x4){0u, 0u, 0u, 0u}; dst[C.lane + 64] = (u32x4){0u, 0u, 0u, 0u}; } }
    }
    __syncthreads();
}

__global__ void __launch_bounds__(512, 2) trunk_fwd(Params prm) {
    extern __shared__ __attribute__((aligned(16))) unsigned char lds_raw[];
#define MKCTX() Ctx C; { int t_ = wave0 * 64 + fresh_lane(); unsigned char* w_ = prm.ws; asm volatile("" : "+s"(w_)); C.lds = (LAS unsigned char*)lds_raw; C.ws = w_; C.p = &prm; \
    C.tid = t_; C.lane = t_ & 63; C.wave = __builtin_amdgcn_readfirstlane(t_ >> 6); C.G = gridDim.x; C.bid = blockIdx.x; C.gw = C.bid * 8 + C.wave; C.ngw = C.G * 8; } \
    unsigned char* ws = C.ws; LAS unsigned char* ring = C.lds; (void)ws; (void)ring
    const int tid0 = threadIdx.x; const int wave0 = __builtin_amdgcn_readfirstlane(tid0 >> 6);
    volatile LAS unsigned* MISC = (volatile LAS unsigned*)((LAS unsigned char*)lds_raw + MISC_OFF);
    if (tid0 < 32) MISC[tid0] = 0u;
    __syncthreads();
    const int lo = prm.ph_lo, hi = prm.ph_hi;
    unsigned* barw = (unsigned*)(prm.ws + WS_CTL) + 4096;
    XcdBarrier bar; bar.bar = barw; bar.x = 0; bar.st = MISC + 8;
    if (hi - lo > 1) bar = xcd_barrier_post(barw, MISC + 8, tid0);
#ifndef ENMASK
#define ENMASK 0xFFFFFFu
#endif
#define EN(j) (((ENMASK) >> (j)) & 1u)
#define IN(k) (lo <= (k) && (k) < hi)
#define SEAM(k) do { if (IN(k) && IN((k) + 1)) xcd_barrier(bar, wave0 * 64 + fresh_lane()); } while (0)

    if (EN(0) && IN(PH_PRO)) { MKCTX(); phase_prologue(C); } SEAM(PH_PRO);
    if (EN(1) && IN(PH_KV)) { MKCTX();
        pg8::Shape g{D, D, D}; SchedKV S{(const char*)(ws + WS_MEMN), (const char*)(ws + WS_W_K), (const char*)(ws + WS_W_V), C.G, C.bid};
        pg8::EpiBf16 E{(bf16*)(ws + WS_KMEM), (bf16*)(ws + WS_VT), 4096, 1.0f};
        pg8::gemm_phase<pg8::EpiBf16, SchedKV>(ring, g, S, E, C.tid);
    } SEAM(PH_KV);

    for (int l = 0; l < DEPTH; ++l) {
        const int pb = PH_L0 + l * PH_PER_LAYER;
        if (EN(2) && IN(pb + 0)) { MKCTX();
            pg8::Shape g{D, D, D}; SchedDense S{(const char*)(ws + WS_XN), (const char*)(ws + WS_W_IN) + (size_t)l * PW * D * 2, NTOK / 256, PW / 256, D, D, C.G, C.bid};
            pg8::EpiProj E{(bf16*)(ws + WS_PROJ1), (bf16*)(ws + WS_PROJ2)};
            pg8::gemm_phase<pg8::EpiProj, SchedDense>(ring, g, S, E, C.tid);
        } SEAM(pb + 0);
        if (EN(3) && IN(pb + 1)) { MKCTX(); phase_prep(C, l); } SEAM(pb + 1);
#if REC_MODE == 0
        if (EN(4) && IN(pb + 2)) { MKCTX(); phase_rec_naive<0, 0>(C, l); } SEAM(pb + 2);
        SEAM(pb + 3);
#elif REC_MODE == 1
        if (EN(4) && IN(pb + 2)) { MKCTX(); phase_r1<1>(C, l); phase_rec_naive<1, 0>(C, l); } SEAM(pb + 2);
        if (EN(17) && IN(pb + 3)) { MKCTX(); phase_r2<1>(C, l); } SEAM(pb + 3);
#else
        if (EN(4) && IN(pb + 2)) { MKCTX(); phase_r1<2>(C, l); } SEAM(pb + 2);
        if (EN(17) && IN(pb + 3)) { MKCTX(); phase_r2<2>(C, l); } SEAM(pb + 3);
#endif
        if (EN(5) && IN(pb + 4)) { MKCTX();
            pg8::Shape g{D, D, D}; SchedDense S{(const char*)(ws + WS_Y), (const char*)(ws + WS_W_OUT) + (size_t)l * D * D * 2, NTOK / 256, 4, D, D, C.G, C.bid};
            pg8::EpiBf16 E{(bf16*)(ws + WS_F), (bf16*)(ws + WS_F), D, 1.0f};
            pg8::gemm_phase<pg8::EpiBf16, SchedDense>(ring, g, S, E, C.tid);
        } SEAM(pb + 4);
        if (EN(6) && IN(pb + 5)) { MKCTX(); phase_ln<0>(C, l, 0, false); } SEAM(pb + 5);
        if (EN(7) && IN(pb + 6)) { MKCTX();
            pg8::Shape g{D, D, D}; SchedDense S{(const char*)(ws + WS_XN), (const char*)(ws + WS_W_Q) + (size_t)l * D * D * 2, NTOK / 256, 4, D, D, C.G, C.bid};
            pg8::EpiBf16 E{(bf16*)(ws + WS_Q), (bf16*)(ws + WS_Q), D, 0.0625f};
            pg8::gemm_phase<pg8::EpiBf16, SchedDense>(ring, g, S, E, C.tid);
        } SEAM(pb + 6);
        if (EN(8) && IN(pb + 7)) { MKCTX();
            pg8::Shape g{256, D, 4096}; SchedAttn S{(const char*)(ws + WS_Q), (const char*)(ws + WS_KMEM), 0, l, C.G, C.bid};
            pg8::EpiSoftmax E{(bf16*)(ws + WS_P)};
            pg8::gemm_phase<pg8::EpiSoftmax, SchedAttn>(ring, g, S, E, C.tid);
        } SEAM(pb + 7);
        if (EN(9) && IN(pb + 8)) { MKCTX();
            pg8::Shape g{256, D, 4096}; SchedAttn S{(const char*)(ws + WS_P), (const char*)(ws + WS_VT), 1, l, C.G, C.bid};
            pg8::EpiBf16 E{(bf16*)(ws + WS_Y), (bf16*)(ws + WS_Y), D, 1.0f};
            pg8::gemm_phase<pg8::EpiBf16, SchedAttn>(ring, g, S, E, C.tid);
        } SEAM(pb + 8);
        if (EN(10) && IN(pb + 9)) { MKCTX();
            pg8::Shape g{D, D, D}; SchedDense S{(const char*)(ws + WS_Y), (const char*)(ws + WS_W_O) + (size_t)l * D * D * 2, NTOK / 256, 4, D, D, C.G, C.bid};
            pg8::EpiBf16 E{(bf16*)(ws + WS_F), (bf16*)(ws + WS_F), D, 1.0f};
            pg8::gemm_phase<pg8::EpiBf16, SchedDense>(ring, g, S, E, C.tid);
        } SEAM(pb + 9);
        if (EN(11) && IN(pb + 10)) { MKCTX(); phase_ln<0>(C, l, 1, false); } SEAM(pb + 10);
        if (EN(12) && IN(pb + 11)) { MKCTX(); phase_route(C, l); convert_experts(C, l); } SEAM(pb + 11);
        if (EN(13) && IN(pb + 12)) { MKCTX(); phase_dispatch(C); } SEAM(pb + 12);
        if (EN(14) && IN(pb + 13)) { MKCTX();
            const int* tt = (const int*)(ws + WS_SMALL + SM_TILE); const int ntiles = __builtin_amdgcn_readfirstlane(tt[0]);
            pg8::Shape g{D, D, D}; SchedMoE S{(const char*)(ws + WS_BUF), (const char*)(ws + WS_GU), tt, ntiles, D, D, C.G, C.bid};
            pg8::EpiSwiGLU E{(bf16*)(ws + WS_H)};
            pg8::gemm_phase<pg8::EpiSwiGLU, SchedMoE>(ring, g, S, E, C.tid);
        } SEAM(pb + 13);
        if (EN(15) && IN(pb + 14)) { MKCTX();
            const int* tt = (const int*)(ws + WS_SMALL + SM_TILE); const int ntiles = __builtin_amdgcn_readfirstlane(tt[0]);
            pg8::Shape g{DEXP, DEXP, DEXP}; SchedMoE S{(const char*)(ws + WS_H), (const char*)(ws + WS_DN), tt, ntiles, DEXP, DEXP, C.G, C.bid};
            pg8::EpiBf16 E{(bf16*)(ws + WS_BUF), (bf16*)(ws + WS_BUF), D, 1.0f};
            pg8::gemm_phase<pg8::EpiBf16, SchedMoE>(ring, g, S, E, C.tid);
        } SEAM(pb + 14);
        if (EN(16) && IN(pb + 15)) { MKCTX(); phase_ln<1>(C, l, 2, l == DEPTH - 1); } SEAM(pb + 15);
    }
#undef IN
#undef SEAM
}

extern "C" void kernel_launch(void* const* d_in, const int* in_sizes, int n_in, void* d_out, int out_size, void* d_ws, size_t ws_size, hipStream_t stream) {
    static int grid = 0;
    if (grid == 0) {
        if (n_in != 25 || out_size != NTOK * D || ws_size < WS_END) { fprintf(stderr, "kernel_launch: unexpected sizes n_in %d out %d ws %zu (need %zu)\n", n_in, out_size, ws_size, (size_t)WS_END); grid = -1; return; }
        int dev = 0, cus = 0, per_cu = 0;
        if (hipGetDevice(&dev) != hipSuccess || hipDeviceGetAttribute(&cus, hipDeviceAttributeMultiprocessorCount, dev) != hipSuccess) { grid = -1; return; }
        if (hipFuncSetAttribute((const void*)trunk_fwd, hipFuncAttributeMaxDynamicSharedMemorySize, LDS_BYTES) != hipSuccess) { fprintf(stderr, "kernel_launch: hipFuncSetAttribute failed\n"); grid = -1; return; }
        if (hipOccupancyMaxActiveBlocksPerMultiprocessor(&per_cu, (const void*)trunk_fwd, 512, LDS_BYTES) != hipSuccess || per_cu < 1) fprintf(stderr, "kernel_launch: occupancy query reports %d\n", per_cu);
        (void)hipGetLastError();
        grid = cus;
    }
    if (grid < 0) return;
    (void)hipMemsetAsync((char*)d_ws + WS_CTL, 0, CTL_ZERO_BYTES, stream);
    Params a{};
    for (int i = 0; i < 25; ++i) a.in[i] = (const float*)d_in[i];
    a.out = (float*)d_out; a.ws = (unsigned char*)d_ws;
#if MK_ONE_LAUNCH
    a.ph_lo = 0; a.ph_hi = N_PHASES;
    hipLaunchKernelGGL(trunk_fwd, dim3(grid), dim3(512), LDS_BYTES, stream, a);
#else
    for (int ph = 0; ph < N_PHASES; ++ph) { a.ph_lo = ph; a.ph_hi = ph + 1; hipLaunchKernelGGL(trunk_fwd, dim3(grid), dim3(512), LDS_BYTES, stream, a); }
#endif
}
```

```cpp
#include <hip/hip_runtime.h>
#include <cstdio>
#include <cstdint>

#ifndef MK_ONE_LAUNCH
#define MK_ONE_LAUNCH 1
#endif

#define LAS __attribute__((address_space(3)))
#define GAS __attribute__((address_space(1)))
typedef unsigned short bf16;
typedef short bf16x8 __attribute__((ext_vector_type(8)));
typedef float f32x4 __attribute__((ext_vector_type(4)));
typedef float f32x2 __attribute__((ext_vector_type(2)));
typedef unsigned u32x4 __attribute__((ext_vector_type(4)));
typedef unsigned u32x2 __attribute__((ext_vector_type(2)));

constexpr int D = 1024, NB = 16, T = 2048, DEPTH = 4, NTOK = NB * T;
constexpr int MEM = 256, NMEM = NB * MEM;
constexpr int INW = 4104, PW = 4096;
constexpr int NEXP = 32, DEXP = 512;
constexpr int MAXROWS = 74240, MAXTILES = MAXROWS / 256;
constexpr float ALPHA = 1.681792830507429f;
constexpr float LN_EPS = 1e-5f, RMS_EPS = 1e-6f, L2_EPS = 1e-6f;

constexpr size_t MiB = 1u << 20;
constexpr size_t WS_CTL = 0, CTL_ZERO_BYTES = 1 * MiB;
constexpr size_t WS_SMALL = 1 * MiB;
constexpr size_t SM_LB = 0, SM_WAB = 16384, SM_CNT = 262144, SM_TILE = 327680;
constexpr size_t WS_W_IN = 2 * MiB;
constexpr size_t WS_W_OUT = 34 * MiB;
constexpr size_t WS_W_Q = 42 * MiB, WS_W_O = 50 * MiB, WS_W_K = 58 * MiB, WS_W_V = 66 * MiB;
constexpr size_t WS_KMEM = 74 * MiB, WS_VT = 106 * MiB;
constexpr size_t WS_MEMN = 138 * MiB;
constexpr size_t WS_X = 146 * MiB;
constexpr size_t WS_XN = 274 * MiB;
constexpr size_t WS_Y = 338 * MiB;
constexpr size_t WS_F = 402 * MiB;
constexpr size_t WS_PROJ2 = 466 * MiB;
constexpr size_t WS_PROJ1 = 562 * MiB;
constexpr int P1W = 2560, P2W = 1536, C_HQ = 0, C_HF = 512, C_HI = 1024, C_HZ = 1536, C_GZ = 2048;
constexpr size_t WS_PROJ = WS_PROJ2;
constexpr size_t WS_Q = WS_PROJ, WS_P = WS_PROJ + 64 * MiB;
constexpr size_t WS_BUF = WS_PROJ, WS_H = WS_PROJ + 146 * MiB;
constexpr int REC_G = 74752, REC_H = 58368;
constexpr size_t WS_RECG = 818 * MiB;
constexpr size_t WS_RECH0 = 402 * MiB  , WS_RECH1 = 964 * MiB  ;
constexpr size_t WS_GU = 722 * MiB;
constexpr size_t WS_DN = 786 * MiB;
constexpr size_t WS_G = 1022 * MiB;
constexpr size_t G_BETA = 512 * 1024, G_ROUTE = 1 * MiB, G_GATES = 1536 * 1024, G_DEST = 1792 * 1024;
constexpr size_t WS_END = 1024 * MiB;

constexpr int RING_BYTES = 131072;
constexpr int EPI_OFF = RING_BYTES;
constexpr int MISC_OFF = 162816;
constexpr int LDS_BYTES = 163840;

#define LDS_WAIT() asm volatile("s_waitcnt lgkmcnt(0)" ::: "memory")
#define VM_WAIT() asm volatile("s_waitcnt vmcnt(0)" ::: "memory")
__device__ __forceinline__ unsigned f2bf(float f) { unsigned u = __builtin_bit_cast(unsigned, f); return (u + 0x7fffu + ((u >> 16) & 1u)) >> 16; }
__device__ __forceinline__ unsigned pk2(float lo, float hi) { return f2bf(lo) | (f2bf(hi) << 16); }
__device__ __forceinline__ float bf2f(unsigned b) { return __builtin_bit_cast(float, b << 16); }
__device__ __forceinline__ float bflo(unsigned w) { return __builtin_bit_cast(float, w << 16); }
__device__ __forceinline__ float bfhi(unsigned w) { return __builtin_bit_cast(float, w & 0xffff0000u); }
__device__ __forceinline__ float shx(float v, int o, int lane) { return __builtin_bit_cast(float, __builtin_amdgcn_ds_bpermute((lane ^ o) << 2, __builtin_bit_cast(int, v))); }
__device__ __forceinline__ float wave_sum(float v, int lane) {
#pragma unroll
    for (int o = 1; o < 64; o <<= 1) v += shx(v, o, lane);
    return v;
}
__device__ __forceinline__ int fresh_lane() { int l; asm volatile("v_mbcnt_lo_u32_b32 %0, -1, 0\n\tv_mbcnt_hi_u32_b32 %0, -1, %0" : "=v"(l)); return l; }
__device__ __forceinline__ float sigmoidf_(float z) { return 1.0f / (1.0f + __expf(-z)); }

namespace pg8 {
constexpr int BM = 256, BK = 64, HALF = 128, HTB = HALF * BK * 2, STAGE_BYTES = 8 * HTB;
__host__ __device__ __forceinline__ int lds_byte(int r, int c) { const int st = (r >> 4) * 2 + (c >> 5), rr = r & 15, cc = c & 31, ob = rr * 64 + cc * 2; return st * 1024 + (ob ^ (((ob >> 9) & 1) << 5)); }
__host__ __device__ __forceinline__ void stage_rc(int b, int& R, int& C) { const int st = b / 1024, sb = b % 1024, swz = sb ^ (((sb >> 9) & 1) << 5); R = (st >> 1) * 16 + swz / 64; C = (st & 1) * 32 + (swz % 64) / 2; }
__host__ __device__ __forceinline__ int perm32(int rho) { const int n = rho >> 4, i = rho & 15; return 8 * (i >> 2) + 4 * n + (i & 3); }

struct Unit { const char* A; const char* B; int pm, pn, aux; };
struct Shape { int K, lda, ldb; };

__device__ __forceinline__ void tile_of(int L, int nM, int nN, int& pm, int& pn) {
    const int nwg = nM * nN; int wgid = L;
    { const int q = nwg / 8, r = nwg % 8, xcd = wgid % 8, off = wgid / 8; wgid = (xcd < r ? xcd * (q + 1) : r * (q + 1) + (xcd - r) * q) + off; }
    const int nig = 8 * nN, gid = wgid / nig, fm = gid * 8, gsz = (nM - fm) < 8 ? (nM - fm) : 8;
    pm = fm + ((wgid % nig) % gsz); pn = (wgid % nig) / gsz;
}

template <class Epi, class Sched>
__device__ __forceinline__ void gemm_phase(LAS unsigned char* lds, const Shape g, const Sched& S, const Epi& E, const int tid) {
    const int wid = __builtin_amdgcn_readfirstlane(tid >> 6), lane = tid & 63, wr = wid >> 2, wc = wid & 3, fr = lane & 15, fq = lane >> 4;
    const int K = g.K, nt = K / BK;
    unsigned voffA[2], voffB[2];
#pragma unroll
    for (int i = 0; i < 2; ++i) { int R, C; stage_rc(tid * 16 + i * 8192, R, C); const int Rb = Epi::PERM ? ((R & ~31) + perm32(R & 31)) : R;
        voffA[i] = (unsigned)(R * g.lda + C) * 2u; voffB[i] = (unsigned)(Rb * g.ldb + C) * 2u; }
    const size_t kstep = (size_t)(BK * 2);
    const size_t hstepA = (size_t)HALF * g.lda * 2, hstepB = (size_t)HALF * g.ldb * 2;
    const unsigned ldsw = (unsigned)wid * 1024u;
    const int aoff = lds_byte(wr * 64 + fr, fq * 8), boff = lds_byte(wc * 32 + fr, fq * 8);
#define PG8_SA(b, h) (((b) * 2 + (h)) * HTB)
#define PG8_SB(b, h) ((4 + (b) * 2 + (h)) * HTB)
#define PG8_STAGE(bufoff, gbase, voff) do { _Pragma("unroll") for (int _i = 0; _i < 2; ++_i) \
        __builtin_amdgcn_global_load_lds((const unsigned*)((const char*)(gbase) + (voff)[_i]), (LAS unsigned*)(lds + (bufoff) + ldsw + _i * 8192), 16, 0, 0); } while (0)
#define PG8_LDA(dst, b, h) do { _Pragma("unroll") for (int m = 0; m < 4; ++m) _Pragma("unroll") for (int k = 0; k < 2; ++k) dst[m][k] = *(const LAS bf16x8*)(lds + PG8_SA(b, h) + aoff + m * 2048 + k * 1024); } while (0)
#define PG8_LDB(dst, b, h) do { _Pragma("unroll") for (int n = 0; n < 2; ++n) _Pragma("unroll") for (int k = 0; k < 2; ++k) dst[n][k] = *(const LAS bf16x8*)(lds + PG8_SB(b, h) + boff + n * 2048 + k * 1024); } while (0)
#define PG8_MMA(ai, bj, At, Bt) do { __builtin_amdgcn_s_setprio(1); _Pragma("unroll") for (int m = 0; m < 4; ++m) _Pragma("unroll") for (int n = 0; n < 2; ++n) _Pragma("unroll") for (int k = 0; k < 2; ++k) \
        acc[ai][bj][m][n] = __builtin_amdgcn_mfma_f32_16x16x32_bf16(Bt[n][k], At[m][k], acc[ai][bj][m][n], 0, 0, 0); __builtin_amdgcn_s_setprio(0); } while (0)
#define PG8_WAIT_V(n) asm volatile("s_waitcnt vmcnt(" #n ")" ::: "memory")
#define PG8_WAIT_L(n) asm volatile("s_waitcnt lgkmcnt(" #n ")" ::: "memory")
#define PG8_BAR __builtin_amdgcn_s_barrier()
#define PG8_SCHED __builtin_amdgcn_sched_barrier(0)
    Unit cur, nxt; int ui = 0;
    if (!S.next(0, cur)) return;
    f32x4 acc[2][2][4][2];
#pragma unroll
    for (int a = 0; a < 2; ++a)
#pragma unroll
        for (int b = 0; b < 2; ++b)
#pragma unroll
            for (int m = 0; m < 4; ++m)
#pragma unroll
                for (int n = 0; n < 2; ++n) acc[a][b][m][n] = (f32x4){0.f, 0.f, 0.f, 0.f};
    bf16x8 At[4][2], B0[2][2], B1[2][2];
    const char* cA = cur.A; const char* cB = cur.B;
    PG8_STAGE(PG8_SB(0, 0), cB, voffB); PG8_STAGE(PG8_SB(0, 1), cB + hstepB, voffB); PG8_STAGE(PG8_SA(0, 0), cA, voffA); PG8_STAGE(PG8_SA(0, 1), cA + hstepA, voffA);
    if (wr == 1) PG8_BAR;
    PG8_WAIT_V(2); PG8_BAR;
    PG8_STAGE(PG8_SB(1, 0), cB + kstep, voffB); PG8_STAGE(PG8_SA(1, 0), cA + kstep, voffA); PG8_STAGE(PG8_SB(1, 1), cB + hstepB + kstep, voffB);
    PG8_WAIT_V(6); PG8_BAR;
    for (;;) {
        const bool has_next = S.next(ui + 1, nxt);
        const char* nA = has_next ? nxt.A : cA; const char* nB = has_next ? nxt.B : cB;
        for (int t = 0; t < nt; t += 2) {
            const bool last = (t == nt - 2);
            const char* a1 = cA + (size_t)(t + 1) * kstep;
            const char* a2 = last ? nA : cA + (size_t)(t + 2) * kstep; const char* b2 = last ? nB : cB + (size_t)(t + 2) * kstep;
            const char* a3 = a2 + kstep; const char* b3 = b2 + kstep;
            PG8_LDB(B0, 0, 0); PG8_LDB(B1, 0, 1); PG8_SCHED; PG8_LDA(At, 0, 0); PG8_STAGE(PG8_SA(1, 1), a1 + hstepA, voffA);
            PG8_WAIT_V(8); PG8_WAIT_L(0); PG8_BAR; PG8_MMA(0, 0, At, B0); PG8_MMA(0, 1, At, B1); PG8_BAR; PG8_SCHED;
            PG8_LDA(At, 0, 1); PG8_STAGE(PG8_SB(0, 0), b2, voffB); PG8_STAGE(PG8_SB(0, 1), b2 + hstepB, voffB); PG8_STAGE(PG8_SA(0, 0), a2, voffA);
            PG8_WAIT_V(8); PG8_WAIT_L(0); PG8_BAR; PG8_MMA(1, 0, At, B0); PG8_MMA(1, 1, At, B1); PG8_BAR; PG8_SCHED;
            PG8_LDB(B0, 1, 0); PG8_LDB(B1, 1, 1); PG8_SCHED; PG8_LDA(At, 1, 0); PG8_STAGE(PG8_SA(0, 1), a2 + hstepA, voffA);
            PG8_WAIT_V(8); PG8_WAIT_L(0); PG8_BAR; PG8_MMA(0, 0, At, B0); PG8_MMA(0, 1, At, B1); PG8_BAR; PG8_SCHED;
            PG8_LDA(At, 1, 1); PG8_STAGE(PG8_SB(1, 0), b3, voffB); PG8_STAGE(PG8_SB(1, 1), b3 + hstepB, voffB); PG8_STAGE(PG8_SA(1, 0), a3, voffA);
            PG8_WAIT_V(8); PG8_WAIT_L(0); PG8_BAR; PG8_MMA(1, 0, At, B0); PG8_MMA(1, 1, At, B1); PG8_BAR; PG8_SCHED;
        }
        if (wr == 0) PG8_BAR;
        E(acc, cur, wr, wc, lds);
        if (!has_next) break;
#pragma unroll
        for (int a = 0; a < 2; ++a)
#pragma unroll
            for (int b = 0; b < 2; ++b)
#pragma unroll
                for (int m = 0; m < 4; ++m)
#pragma unroll
                    for (int n = 0; n < 2; ++n) acc[a][b][m][n] = (f32x4){0.f, 0.f, 0.f, 0.f};
        cur = nxt; cA = nA; cB = nB; ++ui;
        if (wr == 1) PG8_BAR;
    }
    PG8_WAIT_V(0);
    PG8_BAR;
#undef PG8_SA
#undef PG8_SB
#undef PG8_STAGE
#undef PG8_LDA
#undef PG8_LDB
#undef PG8_MMA
#undef PG8_WAIT_V
#undef PG8_WAIT_L
#undef PG8_SCHED
}

struct EpiBf16 {
    static constexpr bool PERM = true;
    bf16* O0; bf16* O1; int ldc; float scale;
    __device__ __forceinline__ void operator()(const f32x4 (&acc)[2][2][4][2], const Unit& u, int wr, int wc, LAS unsigned char*) const {
        const int lane = fresh_lane(), fr = lane & 15, fq = lane >> 4;
        bf16* O = u.aux ? O1 : O0;
        const int row0 = u.pm * BM + wr * 64 + fr, col0 = u.pn * BM + wc * 32 + 8 * fq;
#pragma unroll
        for (int ai = 0; ai < 2; ++ai)
#pragma unroll
            for (int m = 0; m < 4; ++m) { bf16* rowp = O + (size_t)(row0 + ai * HALF + m * 16) * ldc + col0;
#pragma unroll
                for (int bj = 0; bj < 2; ++bj) { const f32x4 v0 = acc[ai][bj][m][0] * scale, v1 = acc[ai][bj][m][1] * scale;
                    u32x4 w; w.x = pk2(v0[0], v0[1]); w.y = pk2(v0[2], v0[3]); w.z = pk2(v1[0], v1[1]); w.w = pk2(v1[2], v1[3]);
                    *(u32x4*)(rowp + bj * HALF) = w; } }
    }
};
struct EpiProj {
    static constexpr bool PERM = true;
    bf16* P1; bf16* P2;
    __device__ __forceinline__ void operator()(const f32x4 (&acc)[2][2][4][2], const Unit& u, int wr, int wc, LAS unsigned char*) const {
        const int lane = fresh_lane(), fr = lane & 15, fq = lane >> 4;
        const bool second = u.pn >= 10; bf16* O = second ? P2 : P1; const int ldc = second ? 1536 : 2560;
        const int row0 = u.pm * BM + wr * 64 + fr, col0 = (second ? u.pn - 10 : u.pn) * BM + wc * 32 + 8 * fq;
#pragma unroll
        for (int ai = 0; ai < 2; ++ai)
#pragma unroll
            for (int m = 0; m < 4; ++m) { bf16* rowp = O + (size_t)(row0 + ai * HALF + m * 16) * ldc + col0;
#pragma unroll
                for (int bj = 0; bj < 2; ++bj) { const f32x4 v0 = acc[ai][bj][m][0], v1 = acc[ai][bj][m][1];
                    u32x4 w; w.x = pk2(v0[0], v0[1]); w.y = pk2(v0[2], v0[3]); w.z = pk2(v1[0], v1[1]); w.w = pk2(v1[2], v1[3]);
                    *(u32x4*)(rowp + bj * HALF) = w; } }
    }
};
struct EpiSwiGLU {
    static constexpr bool PERM = true;
    bf16* H;
    __device__ __forceinline__ void operator()(const f32x4 (&acc)[2][2][4][2], const Unit& u, int wr, int wc, LAS unsigned char*) const {
        const int lane = fresh_lane(), fr = lane & 15, fq = lane >> 4;
        const int row0 = u.pm * BM + wr * 64 + fr, col0 = u.pn * HALF + wc * 32 + 8 * fq;
#pragma unroll
        for (int ai = 0; ai < 2; ++ai)
#pragma unroll
            for (int m = 0; m < 4; ++m) { bf16* rowp = H + (size_t)(row0 + ai * HALF + m * 16) * DEXP + col0;
                float h[8];
#pragma unroll
                for (int n = 0; n < 2; ++n)
#pragma unroll
                    for (int j = 0; j < 4; ++j) { const float gt = acc[ai][0][m][n][j], up = acc[ai][1][m][n][j]; h[n * 4 + j] = gt * sigmoidf_(gt) * up; }
                u32x4 w; w.x = pk2(h[0], h[1]); w.y = pk2(h[2], h[3]); w.z = pk2(h[4], h[5]); w.w = pk2(h[6], h[7]);
                *(u32x4*)rowp = w; }
    }
};
struct EpiSoftmax {
    static constexpr bool PERM = true;
    bf16* P;
    __device__ __forceinline__ void operator()(f32x4 (&acc)[2][2][4][2], const Unit& u, int wr, int wc, LAS unsigned char* lds) const {
        const int lane = fresh_lane(), fr = lane & 15, fq = lane >> 4;
        LAS float* PM = (LAS float*)(lds + EPI_OFF);
        LAS float* PS = (LAS float*)(lds + EPI_OFF + 4096);
        float mx[2][4];
#pragma unroll
        for (int ai = 0; ai < 2; ++ai)
#pragma unroll
            for (int m = 0; m < 4; ++m) { float v = -3.0e38f;
#pragma unroll
                for (int bj = 0; bj < 2; ++bj)
#pragma unroll
                    for (int n = 0; n < 2; ++n)
#pragma unroll
                        for (int j = 0; j < 4; ++j) v = fmaxf(v, acc[ai][bj][m][n][j]);
                v = fmaxf(v, shx(v, 16, lane)); v = fmaxf(v, shx(v, 32, lane));
                if (fq == 0) PM[(ai * HALF + wr * 64 + m * 16 + fr) * 4 + wc] = v; }
        LDS_WAIT(); __builtin_amdgcn_s_barrier(); asm volatile("" ::: "memory");
#pragma unroll
        for (int ai = 0; ai < 2; ++ai)
#pragma unroll
            for (int m = 0; m < 4; ++m) { const f32x4 pm4 = *(const LAS f32x4*)(PM + (ai * HALF + wr * 64 + m * 16 + fr) * 4);
                const float rm = fmaxf(fmaxf(pm4[0], pm4[1]), fmaxf(pm4[2], pm4[3])); float s = 0.f;
#pragma unroll
                for (int bj = 0; bj < 2; ++bj)
#pragma unroll
                    for (int n = 0; n < 2; ++n)
#pragma unroll
                        for (int j = 0; j < 4; ++j) { const float ev = __expf(acc[ai][bj][m][n][j] - rm); acc[ai][bj][m][n][j] = ev; s += ev; }
                s += shx(s, 16, lane); s += shx(s, 32, lane);
                if (fq == 0) PS[(ai * HALF + wr * 64 + m * 16 + fr) * 4 + wc] = s; }
        LDS_WAIT(); __builtin_amdgcn_s_barrier(); asm volatile("" ::: "memory");
        const int row0 = u.pm * BM + wr * 64 + fr, col0 = u.pn * BM + wc * 32 + 8 * fq;
#pragma unroll
        for (int ai = 0; ai < 2; ++ai)
#pragma unroll
            for (int m = 0; m < 4; ++m) { const f32x4 ps4 = *(const LAS f32x4*)(PS + (ai * HALF + wr * 64 + m * 16 + fr) * 4);
                const float inv = 1.0f / ((ps4[0] + ps4[1]) + (ps4[2] + ps4[3]));
                bf16* rowp = P + (size_t)(row0 + ai * HALF + m * 16) * D + col0;
#pragma unroll
                for (int bj = 0; bj < 2; ++bj) { const f32x4 v0 = acc[ai][bj][m][0] * inv, v1 = acc[ai][bj][m][1] * inv; u32x4 w;
                    w.x = pk2(v0[0], v0[1]); w.y = pk2(v0[2], v0[3]); w.z = pk2(v1[0], v1[1]); w.w = pk2(v1[2], v1[3]);
                    *(u32x4*)(rowp + bj * HALF) = w; } }
    }
};
}

#define XB_TMO      128
#define XB_XCNT(j)  (256  + 64 * (j))
#define XB_XSUB(j)  (1280 + 64 * (j))
#define XB_XGEN(j)  (2304 + 64 * (j))
#define XB_TOP      3328
#define XB_TOPGEN   3392
#define XCD_BAR_WORDS 3456
#define XB_SPIN_CAP (1u << 22)
__device__ __forceinline__ unsigned xb_ld(unsigned* p)              { return __hip_atomic_load(p, __ATOMIC_RELAXED, __HIP_MEMORY_SCOPE_AGENT); }
__device__ __forceinline__ unsigned xb_add(unsigned* p, unsigned v) { return __hip_atomic_fetch_add(p, v, __ATOMIC_RELAXED, __HIP_MEMORY_SCOPE_AGENT); }
__device__ __forceinline__ unsigned xb_xcc_id() { return (unsigned)__builtin_amdgcn_s_getreg((3 << 11) | 20) & 0xFu; }
#define XB_SPIN(cond, bar) do { unsigned _sp = 0; while (cond) { __builtin_amdgcn_s_sleep(1); \
    if ((++_sp & 255u) == 0u) { if (xb_ld(&(bar)[XB_TMO])) break; if (_sp > XB_SPIN_CAP) { atomicAdd(&(bar)[XB_TMO], 1u); break; } } } } while (0)
struct XcdBarrier { unsigned* bar; unsigned x; volatile LAS unsigned* st; };
__device__ __forceinline__ XcdBarrier xcd_barrier_post(unsigned* bar, volatile LAS unsigned* st, int tid) {
    XcdBarrier b; b.bar = bar; b.x = xb_xcc_id(); b.st = st;
    if (tid == 0) (void)xb_add(&bar[XB_XCNT(b.x)], 1u);
    return b;
}
__device__ __forceinline__ void xcd_barrier_complete(unsigned* bar, unsigned x, unsigned& nloc, unsigned& nx) {
    const unsigned G = gridDim.x * gridDim.y * gridDim.z;
    unsigned sum, cnt, mine, sp = 0u;
    for (;;) {
        sum = 0u; cnt = 0u; mine = 0u;
#pragma unroll
        for (unsigned j = 0; j < 16; ++j) { const unsigned c = xb_ld(&bar[XB_XCNT(j)]); sum += c; cnt += (c > 0u) ? 1u : 0u; mine = (j == x) ? c : mine; }
        if (sum == G) break;
        __builtin_amdgcn_s_sleep(1);
        if ((++sp & 255u) == 0u) { if (xb_ld(&bar[XB_TMO])) break; if (sp > XB_SPIN_CAP) { atomicAdd(&bar[XB_TMO], 1u); break; } }
    }
    nloc = mine > 0u ? mine : 1u; nx = cnt > 0u ? cnt : 1u;
}
__device__ __forceinline__ void xcd_barrier(const XcdBarrier& b, int tid) {
    asm volatile("s_waitcnt vmcnt(0)" ::: "memory");
    __syncthreads();
    if (tid == 0) {
        unsigned* bar = b.bar;
        __builtin_amdgcn_s_waitcnt(0);
        unsigned nloc = b.st[0], nx = b.st[1];
        if (nloc == 0u) { xcd_barrier_complete(bar, b.x, nloc, nx); b.st[0] = nloc; b.st[1] = nx; }
        const unsigned old = xb_add(&bar[XB_XSUB(b.x)], 1u);
        const unsigned gen = old / nloc;
        if (old + 1u == (gen + 1u) * nloc) {
            __builtin_amdgcn_fence(__ATOMIC_RELEASE, "agent");
            asm volatile("s_waitcnt vmcnt(0)" ::: "memory");
            const unsigned og = xb_add(&bar[XB_TOP], 1u);
            const unsigned tg = og / nx;
            if (og + 1u == (tg + 1u) * nx) xb_add(&bar[XB_TOPGEN], 1u);
            else XB_SPIN(xb_ld(&bar[XB_TOPGEN]) == tg, bar);
            __builtin_amdgcn_fence(__ATOMIC_ACQUIRE, "agent");
            xb_add(&bar[XB_XGEN(b.x)], 1u);
            asm volatile("s_waitcnt vmcnt(0)" ::: "memory");
        } else {
            XB_SPIN(xb_ld(&bar[XB_XGEN(b.x)]) == gen, bar);
            __builtin_amdgcn_fence(__ATOMIC_ACQUIRE, "agent");
            asm volatile("s_waitcnt vmcnt(0)" ::: "memory");
        }
    }
    __syncthreads();
}

struct Params { const float* in[25]; float* out; unsigned char* ws; int ph_lo, ph_hi; };
enum { I_X = 0, I_MEM, I_WIN, I_LBL, I_HGNW, I_CONVW, I_ALOG, I_DTB, I_GDNW, I_WOUT, I_MLNG, I_MLNB, I_WMQ, I_WMK, I_WMV, I_WMO, I_WGRP, I_BGRP, I_WRT, I_BRT, I_WGATE, I_WUP, I_WDOWN, I_LNG, I_LNB };
constexpr int PH_PRO = 0, PH_KV = 1, PH_L0 = 2, PH_PER_LAYER = 16, N_PHASES = PH_L0 + DEPTH * PH_PER_LAYER;

struct Ctx { LAS unsigned char* lds; unsigned char* ws; const Params* p; int tid, lane, wave, gw, ngw, G, bid; };

__device__ __forceinline__ void transpose_item(const float* W, int ldw, int src_col0, int K, bf16* WT, int dst_row0, LAS float* scr, int k0, int lane) {
    float rv[32];
#pragma unroll
    for (int i = 0; i < 32; ++i) { const int kk = 2 * i + (lane >> 5); rv[i] = W[(size_t)(k0 + kk) * ldw + src_col0 + (lane & 31)]; }
#pragma unroll
    for (int i = 0; i < 32; ++i) { const int kk = 2 * i + (lane >> 5); scr[kk * 33 + (lane & 31)] = rv[i]; }
    LDS_WAIT(); asm volatile("" ::: "memory");
    const int c = lane & 7;
#pragma unroll
    for (int j = 0; j < 4; ++j) { const int n = (lane >> 3) + 8 * j; const LAS float* s = scr + (8 * c) * 33 + n;
        u32x4 o; o.x = pk2(s[0 * 33], s[1 * 33]); o.y = pk2(s[2 * 33], s[3 * 33]); o.z = pk2(s[4 * 33], s[5 * 33]); o.w = pk2(s[6 * 33], s[7 * 33]);
        *(u32x4*)(WT + (size_t)(dst_row0 + n) * K + k0 + 8 * c) = o; }
    LDS_WAIT(); asm volatile("" ::: "memory");
}

__device__ __forceinline__ void stage_wab(const Ctx& C, LAS float* wl, int lg) {
    const float* src = C.p->in[I_WIN] + (size_t)lg * D * INW + 3584;
    for (int i = C.tid; i < 8 * D; i += 512) { const int k = i >> 3, o = i & 7; wl[o * D + k] = src[(size_t)k * INW + o]; }
}
__device__ __forceinline__ void gb_row(const Ctx& C, const f32x4 (&y)[4], const LAS float* wl, int lg, size_t tok) {
    float dots[8];
#pragma unroll
    for (int o = 0; o < 8; ++o) { float sacc = 0.f;
#pragma unroll
        for (int j = 0; j < 4; ++j) { const f32x4 wv = *(const LAS f32x4*)(wl + o * D + 4 * (C.lane + 64 * j)); sacc += (y[j][0] * wv[0] + y[j][1] * wv[1]) + (y[j][2] * wv[2] + y[j][3] * wv[3]); }
        dots[o] = sacc; }
#pragma unroll
    for (int off = 1; off < 64; off <<= 1)
#pragma unroll
        for (int o = 0; o < 8; ++o) dots[o] += shx(dots[o], off, C.lane);
    if (C.lane < 4) { const int h = C.lane; float ga = 0.f, gb = 0.f;
#pragma unroll
        for (int o = 0; o < 4; ++o) { ga = (h == o) ? dots[o] : ga; gb = (h == o) ? dots[4 + o] : gb; }
        const float z = ga + C.p->in[I_DTB][lg * 4 + h]; const float sp = fmaxf(z, 0.f) + log1pf(expf(-fabsf(z)));
        ((float*)(C.ws + WS_G))[tok * 4 + h] = -expf(C.p->in[I_ALOG][lg * 4 + h]) * sp;
        ((float*)(C.ws + WS_G + G_BETA))[tok * 4 + h] = 1.0f / (1.0f + expf(-gb)); }
}

__device__ __forceinline__ void phase_prologue(const Ctx& C) {
    const Params& p = *C.p; unsigned char* ws = C.ws;
    LAS float* scr = (LAS float*)(C.lds + C.wave * 16384);
    constexpr int IT_WIN = DEPTH * 16 * 128, IT_SQ = DEPTH * 16 * 32;
    constexpr int NIT = IT_WIN + 5 * IT_SQ;
    for (int it = C.gw; it < NIT; it += C.ngw) {
        int r = it;
        if (r < IT_WIN) { const int l = r / (16 * 128), q = r % (16 * 128), kb = q / 128, nb = q % 128; const int n0 = nb * 32, src = n0 < 2048 ? n0 : (n0 < 2560 ? n0 + 1544 : n0 - 512);
            transpose_item(p.in[I_WIN] + (size_t)l * D * INW, INW, src, D, (bf16*)(ws + WS_W_IN) + (size_t)l * PW * D, n0, scr, kb * 64, C.lane); continue; }
        r -= IT_WIN;
        const int mat = r / IT_SQ, q2 = r % IT_SQ, l = q2 / 512, q = q2 % 512, kb = q / 32, nb = q % 32;
        const float* src; bf16* dst;
        if (mat == 0) { src = p.in[I_WOUT]; dst = (bf16*)(ws + WS_W_OUT); } else if (mat == 1) { src = p.in[I_WMQ]; dst = (bf16*)(ws + WS_W_Q); }
        else if (mat == 2) { src = p.in[I_WMO]; dst = (bf16*)(ws + WS_W_O); } else if (mat == 3) { src = p.in[I_WMK]; dst = (bf16*)(ws + WS_W_K); }
        else { src = p.in[I_WMV]; dst = (bf16*)(ws + WS_W_V); }
        transpose_item(src + (size_t)l * D * D, D, nb * 32, D, dst + (size_t)l * D * D, nb * 32, scr, kb * 64, C.lane);
    }
    LAS float* wl = (LAS float*)(C.lds + 123904);
    stage_wab(C, wl, 0);
    __syncthreads();
    for (int m = C.gw; m < NTOK; m += C.ngw) {
        const f32x4* xr = (const f32x4*)(p.in[I_X] + (size_t)m * D) + C.lane; f32x4* xo = (f32x4*)((float*)(ws + WS_X) + (size_t)m * D) + C.lane;
        u32x2* xb = (u32x2*)((bf16*)(ws + WS_XN) + (size_t)m * D) + C.lane; f32x4 v[4];
#pragma unroll
        for (int j = 0; j < 4; ++j) { v[j] = xr[64 * j]; xo[64 * j] = v[j]; u32x2 w; w.x = pk2(v[j][0], v[j][1]); w.y = pk2(v[j][2], v[j][3]); xb[64 * j] = w; }
        gb_row(C, v, wl, 0, (size_t)m);
    }
    for (int m = C.gw; m < NMEM; m += C.ngw) {
        const f32x4* xr = (const f32x4*)(p.in[I_MEM] + (size_t)m * D) + C.lane; f32x4 v[4]; float s = 0.f;
#pragma unroll
        for (int j = 0; j < 4; ++j) { v[j] = xr[64 * j]; s += (v[j][0] + v[j][1]) + (v[j][2] + v[j][3]); }
        const float mean = wave_sum(s, C.lane) * (1.f / D); float s2 = 0.f;
#pragma unroll
        for (int j = 0; j < 4; ++j) { v[j] = v[j] - mean; s2 += (v[j][0] * v[j][0] + v[j][1] * v[j][1]) + (v[j][2] * v[j][2] + v[j][3] * v[j][3]); }
        const float rstd = 1.0f / sqrtf(wave_sum(s2, C.lane) * (1.f / D) + LN_EPS);
        u32x2* xb = (u32x2*)((bf16*)(ws + WS_MEMN) + (size_t)m * D) + C.lane;
#pragma unroll
        for (int j = 0; j < 4; ++j) { const f32x4 g = ((const f32x4*)p.in[I_MLNG])[C.lane + 64 * j], b = ((const f32x4*)p.in[I_MLNB])[C.lane + 64 * j]; const f32x4 y = v[j] * rstd * g + b;
            u32x2 w; w.x = pk2(y[0], y[1]); w.y = pk2(y[2], y[3]); xb[64 * j] = w; }
    }
    { float* lb = (float*)(ws + WS_SMALL + SM_LB);
      for (int c = C.bid * 512 + C.tid; c < 512; c += C.G * 512) { float z[DEPTH], mx = -3e38f; for (int l = 0; l < DEPTH; ++l) { z[l] = p.in[I_LBL][l * 512 + c]; mx = fmaxf(mx, z[l]); }
          float s = 0.f; for (int l = 0; l < DEPTH; ++l) { z[l] = expf(z[l] - mx); s += z[l]; }
          float cum = 0.f; for (int l = 0; l < DEPTH; ++l) { if (l > 0) cum += z[l] / s; lb[l * 512 + c] = cum; } } }
}

__device__ __forceinline__ void convert_experts(const Ctx& C, int l) {
    const Params& p = *C.p; LAS float* scr = (LAS float*)(C.lds + C.wave * 16384);
    constexpr int IT_G = NEXP * 16 * 16, IT_D = NEXP * 8 * 32;
    for (int it = C.gw; it < 2 * IT_G + IT_D; it += C.ngw) {
        if (it < 2 * IT_G) { const int s = it / IT_G, r = it % IT_G, e = r / 256, q = r % 256, kb = q / 16, nb = q % 16, n0 = nb * 32;
            const float* src = p.in[s ? I_WUP : I_WGATE] + ((size_t)l * NEXP + e) * D * DEXP;
            transpose_item(src, DEXP, n0, D, (bf16*)(C.ws + WS_GU) + (size_t)e * D * D, 256 * (n0 >> 7) + 128 * s + (n0 & 127), scr, kb * 64, C.lane); }
        else { const int r = it - 2 * IT_G, e = r / 256, q = r % 256, kb = q / 32, nb = q % 32;
            transpose_item(p.in[I_WDOWN] + ((size_t)l * NEXP + e) * DEXP * D, D, nb * 32, DEXP, (bf16*)(C.ws + WS_DN) + (size_t)e * D * DEXP, nb * 32, scr, kb * 64, C.lane); }
    }
}

struct SchedDense {
    const char* A; const char* B; int nM, nN, lda, ldb, G, c;
    __device__ __forceinline__ bool next(int i, pg8::Unit& u) const {
        const long L = (long)i * G + c; if (L >= (long)nM * nN) return false;
        int pm, pn; pg8::tile_of((int)L, nM, nN, pm, pn);
        u.pm = pm; u.pn = pn; u.aux = 0; u.A = A + (size_t)pm * 256 * lda * 2; u.B = B + (size_t)pn * 256 * ldb * 2; return true; }
};
struct SchedKV {
    const char* memn; const char* wk; const char* wv; int G, c;
    __device__ __forceinline__ bool next(int i, pg8::Unit& u) const {
        const long L = (long)i * G + c; if (L >= 512) return false;
        const int which = (int)L >> 8; int pm, pn; pg8::tile_of((int)L & 255, 16, 16, pm, pn);
        u.pm = pm; u.pn = pn; u.aux = which;
        u.A = (which ? wv : memn) + (size_t)pm * 256 * D * 2; u.B = (which ? memn : wk) + (size_t)pn * 256 * D * 2; return true; }
};
struct SchedAttn {
    const char* A; const char* B; int pv, l, G, c;
    __device__ __forceinline__ bool next(int i, pg8::Unit& u) const {
        const long L = (long)i * G + c; if (L >= 512) return false;
        const int pm = (int)L >> 2, h = (int)L & 3, b = pm >> 3;
        u.pm = pm; u.pn = h; u.aux = 0; u.A = A + ((size_t)pm * 256 * D + h * 256) * 2;
        u.B = pv ? B + (((size_t)l * D + h * 256) * 4096 + b * 256) * 2 : B + ((size_t)b * 256 * 4096 + l * D + h * 256) * 2; return true; }
};
struct SchedMoE {
    const char* A; const char* B; const int* tile_tab; int ntiles, lda, ldb, G, c;
    __device__ __forceinline__ bool next(int i, pg8::Unit& u) const {
        const long L = (long)i * G + c; if (L >= (long)ntiles * 4) return false;
        int pm, pn; pg8::tile_of((int)L, ntiles, 4, pm, pn); const int e = __builtin_amdgcn_readfirstlane(tile_tab[16 + pm]);
        u.pm = pm; u.pn = pn; u.aux = 0; u.A = A + (size_t)pm * 256 * lda * 2; u.B = B + ((size_t)e * 1024 + pn * 256) * ldb * 2; return true; }
};

__device__ __forceinline__ int img_off(int r, int c, int KS) { const int rr = r & 15, pp = pg8::perm32(c & 31); return ((r >> 4) * KS + (c >> 5)) * 1024 + ((rr * 64 + pp * 2) ^ ((rr >> 3) << 5)); }
__device__ __forceinline__ int u_idx(int t, int v) { return (((v >> 4) * 64 + ((t & 15) >> 2) * 16 + (v & 15)) * 4 + (t >> 4)) * 4 + (t & 3); }
__device__ __forceinline__ f32x4 mfma16(bf16x8 a, bf16x8 b, f32x4 c) { return __builtin_amdgcn_mfma_f32_16x16x32_bf16(a, b, c, 0, 0, 0); }
constexpr int RP = 136;
__device__ __forceinline__ f32x4 score_tile(const LAS bf16* X, const LAS bf16* Y, int mt, int nt, int lane) {
    const int rr = lane & 15, g = lane >> 4; f32x4 acc = (f32x4){0.f, 0.f, 0.f, 0.f};
#pragma unroll
    for (int kk = 0; kk < 4; ++kk) { const bf16x8 a = *(const LAS bf16x8*)(X + (16 * mt + rr) * RP + 32 * kk + 8 * g), b = *(const LAS bf16x8*)(Y + (16 * nt + rr) * RP + 32 * kk + 8 * g); acc = mfma16(a, b, acc); }
    return acc;
}
__device__ __forceinline__ void copy_record(const Ctx& C, unsigned char* dst, int bytes) {
    for (int i = C.tid; i < bytes / 16; i += 512) ((u32x4*)dst)[i] = ((const LAS u32x4*)C.lds)[i];
}

__device__ __forceinline__ unsigned char* rech_ptr(unsigned char* ws, int b, int h, int n) { return ws + (b < 8 ? WS_RECH0 : WS_RECH1) + ((size_t)((b & 7) * 4 + h) * 32 + n) * REC_H; }
__device__ __forceinline__ void r1_hgrn2(const Ctx& C0, int l, int b, int h, int n) {
    Ctx C = C0; { int t_ = C0.tid; asm volatile("" : "+v"(t_)); C.tid = t_; C.lane = t_ & 63; }
    constexpr int O_KT = 16384, O_QK = 32768, O_E = 40960, O_U = 41984, LQ = 59392, LK = LQ + 17408, LS = LK + 17408, LR = LS + 2048;
    LAS unsigned char* L = C.lds; LAS bf16* Qs = (LAS bf16*)(L + LQ); LAS bf16* Ks = (LAS bf16*)(L + LK); LAS float* segt = (LAS float*)(L + LS); LAS bf16* Rw = (LAS bf16*)(L + LR);
    asm volatile("" : "+v"(Qs), "+v"(Ks), "+v"(segt), "+v"(L), "+v"(Rw));
    const bf16* PROJ = (const bf16*)(C.ws + WS_PROJ1);
    const int d = C.tid & 127, seg = C.tid >> 7; const size_t tok0 = (size_t)b * T + n * 64;
    { u32x4 tmp[6];
#pragma unroll
      for (int i = 0; i < 6; ++i) { const int idx = C.tid + 512 * (i & 1), t = idx >> 4, pc = idx & 15, ty = i >> 1; tmp[i] = *(const u32x4*)(PROJ + (tok0 + t) * P1W + ty * 512 + h * 128 + pc * 8); }
#pragma unroll
      for (int i = 0; i < 6; ++i) { const int idx = C.tid + 512 * (i & 1), ty = i >> 1; *(LAS u32x4*)(Rw + ty * 8192 + idx * 8) = tmp[i]; } }
    const float lb = ((const float*)(C.ws + WS_SMALL + SM_LB))[l * 512 + h * 128 + d];
    __syncthreads();
    float run = 0.f;
#pragma unroll 4
    for (int i = 0; i < 16; ++i) { const int t = 16 * seg + i; const float z = bf2f(Rw[8192 + t * 128 + d]);
        const float sg = 1.0f / (1.0f + __expf(-z)), f = lb + (1.f - lb) * sg; run += __logf(f);
        *(LAS bf16*)(L + O_U + 2 * u_idx(t, d)) = Rw[16384 + t * 128 + d]; }
    segt[seg * 128 + d] = run;
    __syncthreads();
    const float s0 = segt[d], s1 = segt[128 + d], s2 = segt[256 + d], s3 = segt[384 + d];
    const float prefix = seg == 0 ? 0.f : seg == 1 ? s0 : seg == 2 ? s0 + s1 : (s0 + s1) + s2, ref = s0 + s1, last = (s0 + s1) + (s2 + s3);
    float c = prefix;
#pragma unroll 4
    for (int i = 0; i < 16; ++i) { const int t = 16 * seg + i; const float qv = bf2f(Rw[t * 128 + d]), z = bf2f(Rw[8192 + t * 128 + d]);
        const float sg = 1.0f / (1.0f + __expf(-z)), f = lb + (1.f - lb) * sg, kv = (1.f - lb) * (1.f - sg); c += __logf(f);
        Qs[t * RP + d] = (bf16)f2bf(qv * __expf(c - ref)); Ks[t * RP + d] = (bf16)f2bf(kv * __expf(ref - c));
        *(LAS bf16*)(L + img_off(t, d, 4)) = (bf16)f2bf(qv * __expf(c));
        *(LAS bf16*)(L + O_KT + img_off(d, t, 2)) = (bf16)f2bf(kv * __expf(last - c)); }
    if (seg == 0) *(LAS float*)(L + O_E + 4 * d) = __expf(last);
    if (seg == 1) *(LAS float*)(L + O_E + 512 + 4 * d) = 0.f;
    __syncthreads();
#pragma unroll
    for (int jj = 0; jj < 2; ++jj) { const int job = C.wave + 8 * jj, mt = job >> 2, nt = job & 3, rr = C.lane & 15, g = C.lane >> 4;
        f32x4 acc = (f32x4){0.f, 0.f, 0.f, 0.f};
        if (nt <= mt) acc = score_tile(Qs, Ks, mt, nt, C.lane);
#pragma unroll
        for (int r = 0; r < 4; ++r) { const int t = 16 * mt + 4 * g + r, sx = 16 * nt + rr; *(LAS bf16*)(L + O_QK + img_off(t, sx, 2)) = (bf16)f2bf((nt <= mt && sx <= t) ? acc[r] : 0.f); } }
    __syncthreads();
    copy_record(C, rech_ptr(C.ws, b, h, n), REC_H);
    __syncthreads();
}

template <int T0> struct SolveRows {
    static __device__ __forceinline__ void run(float (&X)[64], const LAS float* Am, const LAS bf16* Ks, const LAS bf16* Vs, const LAS float* bt, const LAS float* ec, LAS unsigned char* L, int col, bool isw) {
        constexpr int O_U = 58368;
        float a = isw ? bf2f(Ks[T0 * RP + col]) * bt[T0] * ec[T0] : bf2f(Vs[T0 * 128 + col]) * bt[T0];
        float pa[4] = {0.f, 0.f, 0.f, 0.f};
#pragma unroll
        for (int s4 = 0; s4 < (T0 + 3) / 4; ++s4) { const f32x4 av = *(const LAS f32x4*)(Am + T0 * 64 + 4 * s4);
#pragma unroll
            for (int e = 0; e < 4; ++e) if (4 * s4 + e < T0) pa[e] += av[e] * X[4 * s4 + e]; }
        a -= (pa[0] + pa[1]) + (pa[2] + pa[3]);
        X[T0] = a;
        if (isw) *(LAS bf16*)(L + img_off(64 + T0, col, 4)) = (bf16)f2bf(a); else *(LAS bf16*)(L + O_U + 2 * u_idx(T0, col)) = (bf16)f2bf(a);
        SolveRows<T0 + 1>::run(X, Am, Ks, Vs, bt, ec, L, col, isw);
    }
};
template <> struct SolveRows<64> { static __device__ __forceinline__ void run(float (&)[64], const LAS float*, const LAS bf16*, const LAS bf16*, const LAS float*, const LAS float*, LAS unsigned char*, int, bool) {} };

__device__ __forceinline__ void r1_gdn(const Ctx& C0, int l, int b, int h, int n) {
    Ctx C = C0; { int t_ = C0.tid; asm volatile("" : "+v"(t_)); C.tid = t_; C.lane = t_ & 63; }
    constexpr int O_KT = 32768, O_QK = 49152, O_E = 57344, O_U = 58368, LQ = 75776, LK = LQ + 17408, LV = LK + 17408, LA = LV + 16384, LC = LA + 16384, LW = LC + 1024;
    constexpr int RAWB = 17152;
    LAS unsigned char* L = C.lds; LAS bf16* Qs = (LAS bf16*)(L + LQ); LAS bf16* Ks = (LAS bf16*)(L + LK); LAS bf16* Vs = (LAS bf16*)(L + LV); LAS float* Am = (LAS float*)(L + LA);
    LAS float* cs = (LAS float*)(L + LC); LAS float* cw = (LAS float*)(L + LW);
    asm volatile("" : "+v"(Qs), "+v"(Ks), "+v"(Vs), "+v"(Am), "+v"(cs), "+v"(L), "+v"(cw));
    LAS float* ec = cs + 64; LAS float* bt = cs + 128;
    const size_t tok0 = (size_t)b * T + n * 64; const bf16* PROJ = (const bf16*)(C.ws + WS_PROJ2);
    { u32x4 tmp[7];
#pragma unroll
      for (int i = 0; i < 7; ++i) { const int idx = C.tid + 512 * i; tmp[i] = (u32x4){0u, 0u, 0u, 0u};
          if (idx < 3216) { const int ty = idx / 1072, q = idx - ty * 1072, rw = q >> 4, pc = q & 15; if (n > 0 || rw >= 3) tmp[i] = *(const u32x4*)(PROJ + (tok0 + rw - 3) * P2W + ty * 512 + h * 128 + pc * 8); } }
#pragma unroll
      for (int i = 0; i < 7; ++i) { const int idx = C.tid + 512 * i; if (idx < 3216) { const int ty = idx / 1072, q = idx - ty * 1072; *(LAS u32x4*)(L + ty * RAWB + q * 16) = tmp[i]; } } }
    if (C.tid < 384) { const int ty = C.tid >> 7, r = C.tid & 127, k = r >> 5, c4 = r & 31;
        *(LAS f32x4*)(cw + (ty * 4 + k) * 128 + c4 * 4) = *(const f32x4*)(C.p->in[I_CONVW] + ((size_t)l * 4 + k) * 1536 + ty * 512 + h * 128 + c4 * 4); }
    if (C.wave == 7) { float c = ((const float*)(C.ws + WS_G))[(tok0 + C.lane) * 4 + h];
#pragma unroll
        for (int o = 1; o < 64; o <<= 1) { const float up = __builtin_bit_cast(float, __builtin_amdgcn_ds_bpermute(((C.lane - o) & 63) << 2, __builtin_bit_cast(int, c))); if (C.lane >= o) c += up; }
        cs[C.lane] = c; ec[C.lane] = __expf(c); bt[C.lane] = ((const float*)(C.ws + WS_G + G_BETA))[(tok0 + C.lane) * 4 + h]; }
    __syncthreads();
    { const int t = C.tid >> 3, cg = C.tid & 7;
#pragma unroll
      for (int ty = 0; ty < 3; ++ty) { float y[16];
#pragma unroll
          for (int e = 0; e < 16; ++e) y[e] = 0.f;
#pragma unroll
          for (int k = 0; k < 4; ++k) { const LAS unsigned char* rp = L + ty * RAWB + (t + k) * 256 + cg * 32; const u32x4 x0 = *(const LAS u32x4*)rp, x1 = *(const LAS u32x4*)(rp + 16);
              const unsigned xw[8] = {x0.x, x0.y, x0.z, x0.w, x1.x, x1.y, x1.z, x1.w};
#pragma unroll
              for (int e4 = 0; e4 < 4; ++e4) { const f32x4 wv = *(const LAS f32x4*)(cw + (ty * 4 + k) * 128 + cg * 16 + e4 * 4);
                  y[4 * e4] += wv[0] * bflo(xw[2 * e4]); y[4 * e4 + 1] += wv[1] * bfhi(xw[2 * e4]); y[4 * e4 + 2] += wv[2] * bflo(xw[2 * e4 + 1]); y[4 * e4 + 3] += wv[3] * bfhi(xw[2 * e4 + 1]); } }
          float ss = 0.f;
#pragma unroll
          for (int e = 0; e < 16; ++e) { y[e] = y[e] * sigmoidf_(y[e]); ss += y[e] * y[e]; }
          if (ty < 2) { ss += shx(ss, 1, C.lane); ss += shx(ss, 2, C.lane); ss += shx(ss, 4, C.lane); float rn = 1.0f / sqrtf(ss + L2_EPS); if (ty == 0) rn *= 0.08838834764831845f;
#pragma unroll
              for (int e = 0; e < 16; ++e) y[e] *= rn; }
          u32x4 o0, o1; o0.x = pk2(y[0], y[1]); o0.y = pk2(y[2], y[3]); o0.z = pk2(y[4], y[5]); o0.w = pk2(y[6], y[7]); o1.x = pk2(y[8], y[9]); o1.y = pk2(y[10], y[11]); o1.z = pk2(y[12], y[13]); o1.w = pk2(y[14], y[15]);
          LAS bf16* dst = ty == 0 ? Qs + t * RP + cg * 16 : ty == 1 ? Ks + t * RP + cg * 16 : Vs + t * 128 + cg * 16;
          *(LAS u32x4*)dst = o0; *(LAS u32x4*)(dst + 8) = o1; } }
    __syncthreads();
    for (int job = C.wave; job < 26; job += 8) { const int ty = job >= 10; int mt, nt;
        if (ty) { mt = (job - 10) >> 2; nt = (job - 10) & 3; } else { mt = job < 1 ? 0 : job < 3 ? 1 : job < 6 ? 2 : 3; nt = job - (mt * (mt + 1)) / 2; }
        f32x4 acc = (f32x4){0.f, 0.f, 0.f, 0.f};
        if (nt <= mt) acc = score_tile(ty ? Qs : Ks, Ks, mt, nt, C.lane);
        const int rr = C.lane & 15, g = C.lane >> 4;
#pragma unroll
        for (int r = 0; r < 4; ++r) { const int t = 16 * mt + 4 * g + r, sx = 16 * nt + rr; const float dec = __expf(fminf(cs[t] - cs[sx], 0.f));
            if (ty) *(LAS bf16*)(L + O_QK + img_off(t, sx, 2)) = (bf16)f2bf(sx <= t ? acc[r] * dec : 0.f);
            else Am[t * 64 + sx] = sx < t ? bt[t] * acc[r] * dec : 0.f; } }
    __syncthreads();
    if (C.tid < 256) {
        const int j = C.tid, col = j & 127; const bool isw = j >= 128; float X[64];
        SolveRows<0>::run(X, Am, Ks, Vs, bt, ec, L, col, isw);
    } else {
        const int j = C.tid - 256; const float clast = cs[63];
        for (int idx = j; idx < 8192; idx += 256) { const int t = idx >> 7, dd = idx & 127;
            *(LAS bf16*)(L + img_off(t, dd, 4)) = (bf16)f2bf(bf2f(Qs[t * RP + dd]) * ec[t]);
            *(LAS bf16*)(L + O_KT + img_off(dd, t, 2)) = (bf16)f2bf(bf2f(Ks[t * RP + dd]) * __expf(clast - cs[t])); }
        *(LAS float*)(L + O_E + 4 * j) = j < 128 ? __expf(clast) : 0.f;
    }
    __syncthreads();
    copy_record(C, C.ws + WS_RECG + ((size_t)(b * 4 + h) * 32 + n) * REC_G, REC_G);
    __syncthreads();
}

template <int MODE>
__device__ __forceinline__ void phase_r1(const Ctx& C, int l) {
    for (int item = C.bid; item < 4096; item += C.G) {
        const int gd = item < 2048, r = item & 2047, b = r >> 7, h = (r >> 5) & 3, n = r & 31;
        if (gd) { if (MODE == 2) r1_gdn(C, l, b, h, n); } else r1_hgrn2(C, l, b, h, n);
    }
}

template <int MODE>
__device__ __forceinline__ void phase_r2(const Ctx& C, int l) {
    const Params& p = *C.p; unsigned char* ws = C.ws; LAS unsigned char* L = C.lds;
    constexpr int BUFB = 58368; LAS float* OS = (LAS float*)(L + 2 * BUFB);
    asm volatile("" : "+v"(OS));
    const bf16* PROJ = (const bf16*)(ws + WS_PROJ1); bf16* Y = (bf16*)(ws + WS_Y);
    const int rr = C.lane & 15, g = C.lane >> 4, w = C.wave;
    const int aoffl = (rr * 64 + g * 16) ^ ((rr >> 3) << 5);
    for (int item = C.bid; item < NB * 8; item += C.G) {
        const int b = item >> 3, h8 = item & 7, gd = h8 >> 2, h = h8 & 3;
        if (MODE == 1 && gd) continue;
        const unsigned char* rec0 = gd ? ws + WS_RECG + (size_t)(b * 4 + h) * 32 * REC_G : rech_ptr(ws, b, h, 0);
        const int recsz = gd ? REC_G : REC_H, npc = gd ? 57 : 41, o_kt = gd ? 32768 : 16384, o_qk = gd ? 49152 : 32768, o_e = gd ? 57344 : 40960, o_u = gd ? 58368 : 41984;
        const float nw0 = p.in[gd ? I_GDNW : I_HGNW][l * 128 + 2 * C.lane], nw1 = p.in[gd ? I_GDNW : I_HGNW][l * 128 + 2 * C.lane + 1];
        f32x4 S[8];
#pragma unroll
        for (int i = 0; i < 8; ++i) S[i] = (f32x4){0.f, 0.f, 0.f, 0.f};
        __syncthreads();
        u32x4 un0 = *(const u32x4*)(rec0 + o_u + (w * 64 + C.lane) * 32), un1 = *(const u32x4*)(rec0 + o_u + (w * 64 + C.lane) * 32 + 16);
        for (int pc = w; pc < npc; pc += 8) __builtin_amdgcn_global_load_lds((const unsigned*)(rec0 + pc * 1024 + C.lane * 16), (LAS unsigned*)(L + pc * 1024), 16, 0, 0);
        for (int n = 0; n < 32; ++n) {
            LAS unsigned char* B = L + (n & 1) * BUFB; const size_t tok0 = (size_t)b * T + n * 64;
            const u32x4 uc0 = un0, uc1 = un1;
            VM_WAIT(); __builtin_amdgcn_s_barrier(); asm volatile("" ::: "memory");
            unsigned zg[8];
#pragma unroll
            for (int i = 0; i < 8; ++i) zg[i] = *(const unsigned*)(PROJ + (tok0 + 8 * w + i) * P1W + (gd ? C_GZ : C_HZ) + h * 128 + 2 * C.lane);
            if (n + 1 < 32) { const unsigned char* rn = rec0 + (size_t)(n + 1) * recsz;
                un0 = *(const u32x4*)(rn + o_u + (w * 64 + C.lane) * 32); un1 = *(const u32x4*)(rn + o_u + (w * 64 + C.lane) * 32 + 16);
                LAS unsigned char* Bn = L + ((n + 1) & 1) * BUFB;
                for (int pc = w; pc < npc; pc += 8) __builtin_amdgcn_global_load_lds((const unsigned*)(rn + pc * 1024 + C.lane * 16), (LAS unsigned*)(Bn + pc * 1024), 16, 0, 0); }
            bf16x8 sf[4];
#pragma unroll
            for (int kk = 0; kk < 4; ++kk) { u32x4 t4; t4.x = pk2(S[2 * kk][0], S[2 * kk][1]); t4.y = pk2(S[2 * kk][2], S[2 * kk][3]); t4.z = pk2(S[2 * kk + 1][0], S[2 * kk + 1][1]); t4.w = pk2(S[2 * kk + 1][2], S[2 * kk + 1][3]); sf[kk] = __builtin_bit_cast(bf16x8, t4); }
            f32x4 P[8];
#pragma unroll
            for (int m = 0; m < 8; ++m) { P[m] = (f32x4){0.f, 0.f, 0.f, 0.f};
                if (m < 4 || gd) {
#pragma unroll
                    for (int kk = 0; kk < 4; ++kk) P[m] = mfma16(*(const LAS bf16x8*)(B + (m * 4 + kk) * 1024 + aoffl), sf[kk], P[m]); } }
            f32x4 vn[4];
            { const unsigned uu[8] = {uc0.x, uc0.y, uc0.z, uc0.w, uc1.x, uc1.y, uc1.z, uc1.w};
#pragma unroll
              for (int m = 0; m < 4; ++m) vn[m] = (f32x4){bflo(uu[2 * m]), bfhi(uu[2 * m]), bflo(uu[2 * m + 1]), bfhi(uu[2 * m + 1])} - P[4 + m]; }
            bf16x8 vf[2];
#pragma unroll
            for (int kk = 0; kk < 2; ++kk) { u32x4 t4; t4.x = pk2(vn[2 * kk][0], vn[2 * kk][1]); t4.y = pk2(vn[2 * kk][2], vn[2 * kk][3]); t4.z = pk2(vn[2 * kk + 1][0], vn[2 * kk + 1][1]); t4.w = pk2(vn[2 * kk + 1][2], vn[2 * kk + 1][3]); vf[kk] = __builtin_bit_cast(bf16x8, t4); }
#pragma unroll
            for (int m = 0; m < 4; ++m)
#pragma unroll
                for (int kk = 0; kk < 2; ++kk) P[m] = mfma16(*(const LAS bf16x8*)(B + o_qk + (m * 2 + kk) * 1024 + aoffl), vf[kk], P[m]);
#pragma unroll
            for (int i = 0; i < 8; ++i) { const f32x4 ev = *(const LAS f32x4*)(B + o_e + (16 * i + 4 * g) * 4); S[i] = S[i] * ev;
#pragma unroll
                for (int kk = 0; kk < 2; ++kk) S[i] = mfma16(*(const LAS bf16x8*)(B + o_kt + (i * 2 + kk) * 1024 + aoffl), vf[kk], S[i]); }
#pragma unroll
            for (int m = 0; m < 4; ++m)
#pragma unroll
                for (int r = 0; r < 4; ++r) OS[(16 * m + 4 * g + r) * 132 + 16 * w + rr] = P[m][r];
            LDS_WAIT(); __builtin_amdgcn_s_barrier(); asm volatile("" ::: "memory");
#pragma unroll
            for (int i = 0; i < 8; ++i) { const int t = 8 * w + i; const f32x2 o2 = *(const LAS f32x2*)(OS + t * 132 + 2 * C.lane);
                const float r = 1.0f / sqrtf(wave_sum(o2.x * o2.x + o2.y * o2.y, C.lane) * (1.f / 128.f) + RMS_EPS);
                const float z0 = bflo(zg[i]), z1 = bfhi(zg[i]); const float g0 = gd ? z0 * sigmoidf_(z0) : sigmoidf_(z0), g1 = gd ? z1 * sigmoidf_(z1) : sigmoidf_(z1);
                *(unsigned*)(Y + (tok0 + t) * D + gd * 512 + h * 128 + 2 * C.lane) = pk2(o2.x * r * nw0 * g0, o2.y * r * nw1 * g1); }
        }
        VM_WAIT(); __syncthreads();
    }
}

template <int MODE, int GB>
__device__ __forceinline__ void phase_ln(const Ctx& C, int l, int which, bool last) {
    const Params& p = *C.p; unsigned char* ws = C.ws;
    const f32x4* gp = (const f32x4*)(p.in[I_LNG] + ((size_t)l * 3 + which) * D); const f32x4* bp = (const f32x4*)(p.in[I_LNB] + ((size_t)l * 3 + which) * D);
    f32x4 g[4], bb[4];
#pragma unroll
    for (int j = 0; j < 4; ++j) { g[j] = gp[C.lane + 64 * j]; bb[j] = bp[C.lane + 64 * j]; }
    LAS float* wl = (LAS float*)C.lds;
    if (GB && !last) { stage_wab(C, wl, l + 1); __syncthreads(); }
    for (int m0 = C.gw; m0 < NTOK; m0 += 2 * C.ngw) {
        f32x4 v[2][4]; f32x4* xr[2];
#pragma unroll
        for (int q = 0; q < 2; ++q) { const int m = m0 + q * C.ngw;
            xr[q] = (f32x4*)((float*)(ws + WS_X) + (size_t)m * D) + C.lane;
            const u32x2* f0; const u32x2* f1 = nullptr; float w0 = 1.f, w1 = 0.f;
            if (MODE == 0) f0 = (const u32x2*)((const bf16*)(ws + WS_F) + (size_t)m * D) + C.lane;
            else { const int d0 = ((const int*)(ws + WS_G + G_DEST))[2 * m], d1 = ((const int*)(ws + WS_G + G_DEST))[2 * m + 1]; w0 = ((const float*)(ws + WS_G + G_GATES))[2 * m]; w1 = ((const float*)(ws + WS_G + G_GATES))[2 * m + 1];
                f0 = (const u32x2*)((const bf16*)(ws + WS_BUF) + (size_t)d0 * D) + C.lane; f1 = (const u32x2*)((const bf16*)(ws + WS_BUF) + (size_t)d1 * D) + C.lane; }
#pragma unroll
            for (int j = 0; j < 4; ++j) { const f32x4 x = xr[q][64 * j]; const u32x2 a = f0[64 * j]; f32x4 f = (f32x4){bflo(a.x), bfhi(a.x), bflo(a.y), bfhi(a.y)};
                if (MODE == 1) { const u32x2 c = f1[64 * j]; f = f * w0 + (f32x4){bflo(c.x), bfhi(c.x), bflo(c.y), bfhi(c.y)} * w1; }
                v[q][j] = x * ALPHA + f; } }
#pragma unroll
        for (int q = 0; q < 2; ++q) { const int m = m0 + q * C.ngw; float s = 0.f;
#pragma unroll
            for (int j = 0; j < 4; ++j) s += (v[q][j][0] + v[q][j][1]) + (v[q][j][2] + v[q][j][3]);
            const float mean = wave_sum(s, C.lane) * (1.f / D); float s2 = 0.f;
#pragma unroll
            for (int j = 0; j < 4; ++j) { v[q][j] = v[q][j] - mean; s2 += (v[q][j][0] * v[q][j][0] + v[q][j][1] * v[q][j][1]) + (v[q][j][2] * v[q][j][2] + v[q][j][3] * v[q][j][3]); }
            const float rstd = 1.0f / sqrtf(wave_sum(s2, C.lane) * (1.f / D) + LN_EPS);
            u32x2* xb = (u32x2*)((bf16*)(ws + WS_XN) + (size_t)m * D) + C.lane; f32x4* xo = (f32x4*)(p.out + (size_t)m * D) + C.lane;
#pragma unroll
            for (int j = 0; j < 4; ++j) { const f32x4 y = v[q][j] * rstd * g[j] + bb[j]; v[q][j] = y; xr[q][64 * j] = y; u32x2 w; w.x = pk2(y[0], y[1]); w.y = pk2(y[2], y[3]); xb[64 * j] = w; if (last) xo[64 * j] = y; }
            if (GB && !last) gb_row(C, v[q], wl, l + 1, (size_t)m); }
    }
    if (GB) __syncthreads();
}

__device__ __forceinline__ void phase_route(const Ctx& C, int l) {
    const Params& p = *C.p; unsigned char* ws = C.ws;
    LAS float* xs = (LAS float*)C.lds;
    LAS float* wsh = xs + 128 * 65;
    LAS float* lg = wsh + 64 * 36;
    LAS int* es = (LAS int*)(lg + 128 * 36);
    LAS int* rk = es + 256;
    const float* X = (const float*)(ws + WS_X);
    const float* wg = p.in[I_WGRP] + (size_t)l * D * 4; const float* wr_ = p.in[I_WRT] + (size_t)l * D * 32;
    const int t = C.tid & 127, og = C.tid >> 7;
    for (int item = C.bid; item < 256; item += C.G) {
        const size_t tok0 = (size_t)item * 128;
        float acc[9];
#pragma unroll
        for (int i = 0; i < 9; ++i) acc[i] = 0.f;
        float xr_[16], wr5[5];
#pragma unroll
        for (int i = 0; i < 16; ++i) { const int idx = C.tid + 512 * i, r = idx >> 6, c = idx & 63; xr_[i] = X[(tok0 + r) * D + c]; }
#pragma unroll
        for (int i = 0; i < 5; ++i) { const int idx = C.tid + 512 * i; wr5[i] = 0.f; if (idx < 64 * 36) { const int k = idx / 36, o = idx % 36; wr5[i] = o < 4 ? wg[(size_t)k * 4 + o] : wr_[(size_t)k * 32 + o - 4]; } }
        for (int k0 = 0; k0 < D; k0 += 64) {
            __syncthreads();
#pragma unroll
            for (int i = 0; i < 16; ++i) { const int idx = C.tid + 512 * i, r = idx >> 6, c = idx & 63; xs[r * 65 + c] = xr_[i]; }
#pragma unroll
            for (int i = 0; i < 5; ++i) { const int idx = C.tid + 512 * i; if (idx < 64 * 36) wsh[idx] = wr5[i]; }
            __syncthreads();
            if (k0 + 64 < D) {
#pragma unroll
                for (int i = 0; i < 16; ++i) { const int idx = C.tid + 512 * i, r = idx >> 6, c = idx & 63; xr_[i] = X[(tok0 + r) * D + k0 + 64 + c]; }
#pragma unroll
                for (int i = 0; i < 5; ++i) { const int idx = C.tid + 512 * i; if (idx < 64 * 36) { const int k = idx / 36, o = idx % 36; wr5[i] = o < 4 ? wg[(size_t)(k0 + 64 + k) * 4 + o] : wr_[(size_t)(k0 + 64 + k) * 32 + o - 4]; } } }
#pragma unroll 8
            for (int k = 0; k < 64; ++k) { const float xv = xs[t * 65 + k];
#pragma unroll
                for (int i = 0; i < 9; ++i) acc[i] += xv * wsh[k * 36 + og * 9 + i]; }
        }
#pragma unroll
        for (int i = 0; i < 9; ++i) lg[t * 36 + og * 9 + i] = acc[i];
        __syncthreads();
        int e0 = 0, e1 = 0; float w0 = 0.f, w1 = 0.f;
        if (C.tid < 128) {
            float gl[4]; int gsel = 0;
#pragma unroll
            for (int j = 0; j < 4; ++j) gl[j] = lg[C.tid * 36 + j] + p.in[I_BGRP][l * 4 + j];
#pragma unroll
            for (int j = 1; j < 4; ++j) if (gl[j] > gl[gsel]) gsel = j;
            float gsum = 0.f;
#pragma unroll
            for (int j = 0; j < 4; ++j) gsum += expf(gl[j] - gl[gsel]);
            const float ggate = 1.0f / gsum;
            float el[8];
#pragma unroll
            for (int j = 0; j < 8; ++j) el[j] = lg[C.tid * 36 + 4 + gsel * 8 + j] + p.in[I_BRT][l * 32 + gsel * 8 + j];
            int t1 = 0;
#pragma unroll
            for (int j = 1; j < 8; ++j) if (el[j] > el[t1]) t1 = j;
            int t2 = (t1 == 0) ? 1 : 0;
#pragma unroll
            for (int j = 0; j < 8; ++j) if (j != t1 && el[j] > el[t2]) t2 = j;
            const float ex = expf(el[t2] - el[t1]); w0 = ggate / (1.f + ex); w1 = ggate * ex / (1.f + ex);
            e0 = gsel * 8 + t1; e1 = gsel * 8 + t2; es[2 * C.tid] = e0; es[2 * C.tid + 1] = e1;
        }
        __syncthreads();
        if (C.tid < 32) { int cnt = 0; for (int a = 0; a < 256; ++a) if (es[a] == C.tid) { rk[a] = cnt; ++cnt; } ((int*)(ws + WS_SMALL + SM_CNT))[item * 32 + C.tid] = cnt; }
        __syncthreads();
        if (C.tid < 128) { const size_t tok = tok0 + C.tid; int* ro = (int*)(ws + WS_G + G_ROUTE) + tok * 4; ro[0] = e0; ro[1] = e1; ro[2] = rk[2 * C.tid]; ro[3] = rk[2 * C.tid + 1];
            float* gt = (float*)(ws + WS_G + G_GATES) + tok * 2; gt[0] = w0; gt[1] = w1; }
    }
    __syncthreads();
}

__device__ __forceinline__ void phase_dispatch(const Ctx& C) {
    unsigned char* ws = C.ws;
    LAS int* cn = (LAS int*)C.lds;
    LAS int* tot = cn + 8192; LAS int* bef = tot + 32; LAS int* base = bef + 32; LAS int* pst = base + 32; LAS int* dl = pst + 32;
    const int* cnt_all = (const int*)(ws + WS_SMALL + SM_CNT);
    bf16* BUF = (bf16*)(ws + WS_BUF); const bf16* XN = (const bf16*)(ws + WS_XN);
    for (int item = C.bid; item < 256; item += C.G) {
        __syncthreads();
        for (int i = C.tid; i < 8192; i += 512) cn[i] = cnt_all[i];
        __syncthreads();
        if (C.tid < 32) { int s = 0, bsum = 0; for (int b = 0; b < 256; ++b) { const int c = cn[b * 32 + C.tid]; if (b < item) bsum += c; s += c; } tot[C.tid] = s; bef[C.tid] = bsum; }
        __syncthreads();
        if (C.tid == 0) { int ps = 0; for (int e = 0; e < 32; ++e) { pst[e] = ps; base[e] = ps + bef[e]; ps += (tot[e] + 255) & ~255; }
            if (item == 0) { int* tt = (int*)(ws + WS_SMALL + SM_TILE); tt[0] = ps >> 8; for (int e = 0; e < 32; ++e) for (int r = pst[e]; r < pst[e] + ((tot[e] + 255) & ~255); r += 256) tt[16 + (r >> 8)] = e; } }
        __syncthreads();
        if (C.tid < 128) { const size_t tok = (size_t)item * 128 + C.tid; const int* ro = (const int*)(ws + WS_G + G_ROUTE) + tok * 4; const int d0 = base[ro[0]] + ro[2], d1 = base[ro[1]] + ro[3];
            int* dd = (int*)(ws + WS_G + G_DEST) + tok * 2; dd[0] = d0; dd[1] = d1; dl[2 * C.tid] = d0; dl[2 * C.tid + 1] = d1; }
        __syncthreads();
        for (int a0 = C.wave * 32; a0 < C.wave * 32 + 32; a0 += 8) { u32x4 t0[8], t1[8];
#pragma unroll
            for (int q = 0; q < 8; ++q) { const size_t tok = (size_t)item * 128 + ((a0 + q) >> 1); const u32x4* src = (const u32x4*)(XN + tok * D); t0[q] = src[C.lane]; t1[q] = src[C.lane + 64]; }
#pragma unroll
            for (int q = 0; q < 8; ++q) { u32x4* dst = (u32x4*)(BUF + (size_t)dl[a0 + q] * D); dst[C.lane] = t0[q]; dst[C.lane + 64] = t1[q]; } }
        if (item < 32) { const int e = item, r0 = pst[e] + tot[e], r1 = pst[e] + ((tot[e] + 255) & ~255);
            for (int r = r0 + C.wave; r < r1; r += 8) { u32x4* dst = (u32x4*)(BUF + (size_t)r * D); dst[C.lane] = (u32x4){0u, 0u, 0u, 0u}; dst[C.lane + 64] = (u32x4){0u, 0u, 0u, 0u}; } }
    }
    __syncthreads();
}

__global__ void __launch_bounds__(512, 2) trunk_fwd(Params prm) {
    extern __shared__ __attribute__((aligned(16))) unsigned char lds_raw[];
#define MKCTX() Ctx C; { int t_ = wave0 * 64 + fresh_lane(); unsigned char* w_ = prm.ws; asm volatile("" : "+s"(w_)); C.lds = (LAS unsigned char*)lds_raw; C.ws = w_; C.p = &prm; \
    C.tid = t_; C.lane = t_ & 63; C.wave = __builtin_amdgcn_readfirstlane(t_ >> 6); C.G = gridDim.x; C.bid = blockIdx.x; C.gw = C.bid * 8 + C.wave; C.ngw = C.G * 8; } \
    unsigned char* ws = C.ws; LAS unsigned char* ring = C.lds; (void)ws; (void)ring
    const int tid0 = threadIdx.x; const int wave0 = __builtin_amdgcn_readfirstlane(tid0 >> 6);
    volatile LAS unsigned* MISC = (volatile LAS unsigned*)((LAS unsigned char*)lds_raw + MISC_OFF);
    if (tid0 < 32) MISC[tid0] = 0u;
    __syncthreads();
    const int lo = prm.ph_lo, hi = prm.ph_hi;
    unsigned* barw = (unsigned*)(prm.ws + WS_CTL) + 4096;
    XcdBarrier bar; bar.bar = barw; bar.x = 0; bar.st = MISC + 8;
    if (hi - lo > 1) bar = xcd_barrier_post(barw, MISC + 8, tid0);
#ifndef ENMASK
#define ENMASK 0xFFFFFFu
#endif
#define EN(j) (((ENMASK) >> (j)) & 1u)
#ifndef DUPMASK
#define DUPMASK 0u
#endif
#define REPS(j) int nrep_ = 1 + (int)(((DUPMASK) >> (j)) & 1u); if ((DUPMASK) != 0u) asm volatile("" : "+s"(nrep_)); for (int rep_ = 0; rep_ < nrep_; ++rep_)
#define IN(k) (lo <= (k) && (k) < hi)
#define SEAM(k) do { if (IN(k) && IN((k) + 1)) xcd_barrier(bar, wave0 * 64 + fresh_lane()); } while (0)

    if (EN(0) && IN(PH_PRO)) { REPS(0) { MKCTX(); phase_prologue(C); } } SEAM(PH_PRO);
    if (EN(1) && IN(PH_KV)) { REPS(1) { MKCTX();
        pg8::Shape g{D, D, D}; SchedKV S{(const char*)(ws + WS_MEMN), (const char*)(ws + WS_W_K), (const char*)(ws + WS_W_V), C.G, C.bid};
        pg8::EpiBf16 E{(bf16*)(ws + WS_KMEM), (bf16*)(ws + WS_VT), 4096, 1.0f};
        pg8::gemm_phase<pg8::EpiBf16, SchedKV>(ring, g, S, E, C.tid);
    } } SEAM(PH_KV);

    for (int l = 0; l < DEPTH; ++l) {
        const int pb = PH_L0 + l * PH_PER_LAYER;
        if (EN(2) && IN(pb + 0)) { REPS(2) { MKCTX();
            pg8::Shape g{D, D, D}; SchedDense S{(const char*)(ws + WS_XN), (const char*)(ws + WS_W_IN) + (size_t)l * PW * D * 2, NTOK / 256, PW / 256, D, D, C.G, C.bid};
            pg8::EpiProj E{(bf16*)(ws + WS_PROJ1), (bf16*)(ws + WS_PROJ2)};
            pg8::gemm_phase<pg8::EpiProj, SchedDense>(ring, g, S, E, C.tid);
        } } SEAM(pb + 0);
        if (EN(4) && IN(pb + 2)) { REPS(4) { MKCTX(); phase_r1<2>(C, l); } } SEAM(pb + 2);
        if (EN(17) && IN(pb + 3)) { REPS(17) { MKCTX(); phase_r2<2>(C, l); } } SEAM(pb + 3);
        if (EN(5) && IN(pb + 4)) { REPS(5) { MKCTX();
            pg8::Shape g{D, D, D}; SchedDense S{(const char*)(ws + WS_Y), (const char*)(ws + WS_W_OUT) + (size_t)l * D * D * 2, NTOK / 256, 4, D, D, C.G, C.bid};
            pg8::EpiBf16 E{(bf16*)(ws + WS_F), (bf16*)(ws + WS_F), D, 1.0f};
            pg8::gemm_phase<pg8::EpiBf16, SchedDense>(ring, g, S, E, C.tid);
        } } SEAM(pb + 4);
        if (EN(6) && IN(pb + 5)) { REPS(6) { MKCTX(); phase_ln<0, 0>(C, l, 0, false); } } SEAM(pb + 5);
        if (EN(7) && IN(pb + 6)) { REPS(7) { MKCTX();
            pg8::Shape g{D, D, D}; SchedDense S{(const char*)(ws + WS_XN), (const char*)(ws + WS_W_Q) + (size_t)l * D * D * 2, NTOK / 256, 4, D, D, C.G, C.bid};
            pg8::EpiBf16 E{(bf16*)(ws + WS_Q), (bf16*)(ws + WS_Q), D, 0.0625f};
            pg8::gemm_phase<pg8::EpiBf16, SchedDense>(ring, g, S, E, C.tid);
        } } SEAM(pb + 6);
        if (EN(8) && IN(pb + 7)) { REPS(8) { MKCTX();
            pg8::Shape g{256, D, 4096}; SchedAttn S{(const char*)(ws + WS_Q), (const char*)(ws + WS_KMEM), 0, l, C.G, C.bid};
            pg8::EpiSoftmax E{(bf16*)(ws + WS_P)};
            pg8::gemm_phase<pg8::EpiSoftmax, SchedAttn>(ring, g, S, E, C.tid);
        } } SEAM(pb + 7);
        if (EN(9) && IN(pb + 8)) { REPS(9) { MKCTX();
            pg8::Shape g{256, D, 4096}; SchedAttn S{(const char*)(ws + WS_P), (const char*)(ws + WS_VT), 1, l, C.G, C.bid};
            pg8::EpiBf16 E{(bf16*)(ws + WS_Y), (bf16*)(ws + WS_Y), D, 1.0f};
            pg8::gemm_phase<pg8::EpiBf16, SchedAttn>(ring, g, S, E, C.tid);
        } } SEAM(pb + 8);
        if (EN(10) && IN(pb + 9)) { REPS(10) { MKCTX();
            pg8::Shape g{D, D, D}; SchedDense S{(const char*)(ws + WS_Y), (const char*)(ws + WS_W_O) + (size_t)l * D * D * 2, NTOK / 256, 4, D, D, C.G, C.bid};
            pg8::EpiBf16 E{(bf16*)(ws + WS_F), (bf16*)(ws + WS_F), D, 1.0f};
            pg8::gemm_phase<pg8::EpiBf16, SchedDense>(ring, g, S, E, C.tid);
        } } SEAM(pb + 9);
        if (EN(11) && IN(pb + 10)) { REPS(11) { MKCTX(); phase_ln<0, 0>(C, l, 1, false); } } SEAM(pb + 10);
        if (EN(12) && IN(pb + 11)) { REPS(12) { MKCTX(); phase_route(C, l); convert_experts(C, l); } } SEAM(pb + 11);
        if (EN(13) && IN(pb + 12)) { REPS(13) { MKCTX(); phase_dispatch(C); } } SEAM(pb + 12);
        if (EN(14) && IN(pb + 13)) { REPS(14) { MKCTX();
            const int* tt = (const int*)(ws + WS_SMALL + SM_TILE); const int ntiles = __builtin_amdgcn_readfirstlane(tt[0]);
            pg8::Shape g{D, D, D}; SchedMoE S{(const char*)(ws + WS_BUF), (const char*)(ws + WS_GU), tt, ntiles, D, D, C.G, C.bid};
            pg8::EpiSwiGLU E{(bf16*)(ws + WS_H)};
            pg8::gemm_phase<pg8::EpiSwiGLU, SchedMoE>(ring, g, S, E, C.tid);
        } } SEAM(pb + 13);
        if (EN(15) && IN(pb + 14)) { REPS(15) { MKCTX();
            const int* tt = (const int*)(ws + WS_SMALL + SM_TILE); const int ntiles = __builtin_amdgcn_readfirstlane(tt[0]);
            pg8::Shape g{DEXP, DEXP, DEXP}; SchedMoE S{(const char*)(ws + WS_H), (const char*)(ws + WS_DN), tt, ntiles, DEXP, DEXP, C.G, C.bid};
            pg8::EpiBf16 E{(bf16*)(ws + WS_BUF), (bf16*)(ws + WS_BUF), D, 1.0f};
            pg8::gemm_phase<pg8::EpiBf16, SchedMoE>(ring, g, S, E, C.tid);
        } } SEAM(pb + 14);
        if (EN(16) && IN(pb + 15)) { REPS(16) { MKCTX(); phase_ln<1, 1>(C, l, 2, l == DEPTH - 1); } } SEAM(pb + 15);
    }
#undef IN
#undef SEAM
}

extern "C" void kernel_launch(void* const* d_in, const int* in_sizes, int n_in, void* d_out, int out_size, void* d_ws, size_t ws_size, hipStream_t stream) {
    static int grid = 0;
    if (grid == 0) {
        if (n_in != 25 || out_size != NTOK * D || ws_size < WS_END) { fprintf(stderr, "kernel_launch: unexpected sizes n_in %d out %d ws %zu (need %zu)\n", n_in, out_size, ws_size, (size_t)WS_END); grid = -1; return; }
        int dev = 0, cus = 0, per_cu = 0;
        if (hipGetDevice(&dev) != hipSuccess || hipDeviceGetAttribute(&cus, hipDeviceAttributeMultiprocessorCount, dev) != hipSuccess) { grid = -1; return; }
        if (hipFuncSetAttribute((const void*)trunk_fwd, hipFuncAttributeMaxDynamicSharedMemorySize, LDS_BYTES) != hipSuccess) { fprintf(stderr, "kernel_launch: hipFuncSetAttribute failed\n"); grid = -1; return; }
        if (hipOccupancyMaxActiveBlocksPerMultiprocessor(&per_cu, (const void*)trunk_fwd, 512, LDS_BYTES) != hipSuccess || per_cu < 1) fprintf(stderr, "kernel_launch: occupancy query reports %d\n", per_cu);
        (void)hipGetLastError();
        grid = cus;
    }
    if (grid < 0) return;
    (void)hipMemsetAsync((char*)d_ws + WS_CTL, 0, CTL_ZERO_BYTES, stream);
    Params a{};
    for (int i = 0; i < 25; ++i) a.in[i] = (const float*)d_in[i];
    a.out = (float*)d_out; a.ws = (unsigned char*)d_ws;
#if MK_ONE_LAUNCH
    a.ph_lo = 0; a.ph_hi = N_PHASES;
    hipLaunchKernelGGL(trunk_fwd, dim3(grid), dim3(512), LDS_BYTES, stream, a);
#else
    for (int ph = 0; ph < N_PHASES; ++ph) { a.ph_lo = ph; a.ph_hi = ph + 1; hipLaunchKernelGGL(trunk_fwd, dim3(grid), dim3(512), LDS_BYTES, stream, a); }
#endif
}
```

```cpp
#include <hip/hip_runtime.h>
#include <cstdio>
#include <cstdint>

#ifndef MK_ONE_LAUNCH
#define MK_ONE_LAUNCH 1
#endif

#define LAS __attribute__((address_space(3)))
#define GAS __attribute__((address_space(1)))
typedef unsigned short bf16;
typedef short bf16x8 __attribute__((ext_vector_type(8)));
typedef float f32x4 __attribute__((ext_vector_type(4)));
typedef float f32x2 __attribute__((ext_vector_type(2)));
typedef unsigned u32x4 __attribute__((ext_vector_type(4)));
typedef unsigned u32x2 __attribute__((ext_vector_type(2)));

constexpr int D = 1024, NB = 16, T = 2048, DEPTH = 4, NTOK = NB * T;
constexpr int MEM = 256, NMEM = NB * MEM;
constexpr int INW = 4104, PW = 4096;
constexpr int NEXP = 32, DEXP = 512;
constexpr int MAXROWS = 74240, MAXTILES = MAXROWS / 256;
constexpr float ALPHA = 1.681792830507429f;
constexpr float LN_EPS = 1e-5f, RMS_EPS = 1e-6f, L2_EPS = 1e-6f;

constexpr size_t MiB = 1u << 20;
constexpr size_t WS_CTL = 0, CTL_ZERO_BYTES = 1 * MiB;
constexpr size_t WS_SMALL = 1 * MiB;
constexpr size_t SM_LB = 0, SM_WAB = 16384, SM_CNT = 262144, SM_TILE = 327680;
constexpr size_t WS_W_IN = 2 * MiB;
constexpr size_t WS_W_OUT = 34 * MiB;
constexpr size_t WS_W_Q = 42 * MiB, WS_W_O = 50 * MiB, WS_W_K = 58 * MiB, WS_W_V = 66 * MiB;
constexpr size_t WS_KMEM = 74 * MiB, WS_VT = 106 * MiB;
constexpr size_t WS_MEMN = 138 * MiB;
constexpr size_t WS_X = 146 * MiB;
constexpr size_t WS_XN = 274 * MiB;
constexpr size_t WS_Y = 338 * MiB;
constexpr size_t WS_F = 402 * MiB;
constexpr size_t WS_PROJ2 = 466 * MiB;
constexpr size_t WS_PROJ1 = 562 * MiB;
constexpr int P1W = 2560, P2W = 1536, C_HQ = 0, C_HF = 512, C_HI = 1024, C_HZ = 1536, C_GZ = 2048;
constexpr size_t WS_PROJ = WS_PROJ2;
constexpr size_t WS_Q = WS_PROJ, WS_P = WS_PROJ + 64 * MiB;
constexpr size_t WS_BUF = WS_PROJ, WS_H = WS_PROJ + 146 * MiB;
constexpr int REC_G = 74752, REC_H = 58368;
constexpr size_t WS_RECG = 818 * MiB;
constexpr size_t WS_RECH0 = 402 * MiB  , WS_RECH1 = 964 * MiB  ;
constexpr size_t WS_GU = 722 * MiB;
constexpr size_t WS_DN = 786 * MiB;
constexpr size_t WS_G = 1022 * MiB;
constexpr size_t G_BETA = 512 * 1024, G_ROUTE = 1 * MiB, G_GATES = 1536 * 1024, G_DEST = 1792 * 1024;
constexpr size_t WS_END = 1024 * MiB;

constexpr int RING_BYTES = 131072;
constexpr int EPI_OFF = RING_BYTES;
constexpr int MISC_OFF = 162816;
constexpr int LDS_BYTES = 163840;

#define LDS_WAIT() asm volatile("s_waitcnt lgkmcnt(0)" ::: "memory")
#define VM_WAIT() asm volatile("s_waitcnt vmcnt(0)" ::: "memory")
__device__ __forceinline__ unsigned f2bf(float f) { unsigned u = __builtin_bit_cast(unsigned, f); return (u + 0x7fffu + ((u >> 16) & 1u)) >> 16; }
typedef __bf16 bf16x2_t __attribute__((ext_vector_type(2)));
__device__ __forceinline__ unsigned pk2(float lo, float hi) { const f32x2 v = {lo, hi}; return __builtin_bit_cast(unsigned, __builtin_convertvector(v, bf16x2_t)); }
__device__ __forceinline__ float bf2f(unsigned b) { return __builtin_bit_cast(float, b << 16); }
__device__ __forceinline__ float bflo(unsigned w) { return __builtin_bit_cast(float, w << 16); }
__device__ __forceinline__ float bfhi(unsigned w) { return __builtin_bit_cast(float, w & 0xffff0000u); }
__device__ __forceinline__ float shx(float v, int o, int lane) { return __builtin_bit_cast(float, __builtin_amdgcn_ds_bpermute((lane ^ o) << 2, __builtin_bit_cast(int, v))); }
template <int N> __device__ __forceinline__ float dpp_ror(float v) { return __builtin_bit_cast(float, __builtin_amdgcn_update_dpp(0, __builtin_bit_cast(int, v), 0x120 + N, 0xf, 0xf, false)); }
__device__ __forceinline__ float row16_sum(float v) { v += dpp_ror<8>(v); v += dpp_ror<4>(v); v += dpp_ror<2>(v); v += dpp_ror<1>(v); return v; }
__device__ __forceinline__ float wave_sum(float v, int lane) { v = row16_sum(v); v += shx(v, 16, lane); v += shx(v, 32, lane); return v; }
__device__ __forceinline__ int fresh_lane() { int l; asm volatile("v_mbcnt_lo_u32_b32 %0, -1, 0\n\tv_mbcnt_hi_u32_b32 %0, -1, %0" : "=v"(l)); return l; }
__device__ __forceinline__ float sigmoidf_(float z) { return __builtin_amdgcn_rcpf(1.0f + __expf(-z)); }

namespace pg8 {
constexpr int BM = 256, BK = 64, HALF = 128, HTB = HALF * BK * 2, STAGE_BYTES = 8 * HTB;
__host__ __device__ __forceinline__ int lds_byte(int r, int c) { const int st = (r >> 4) * 2 + (c >> 5), rr = r & 15, cc = c & 31, ob = rr * 64 + cc * 2; return st * 1024 + (ob ^ (((ob >> 9) & 1) << 5)); }
__host__ __device__ __forceinline__ void stage_rc(int b, int& R, int& C) { const int st = b / 1024, sb = b % 1024, swz = sb ^ (((sb >> 9) & 1) << 5); R = (st >> 1) * 16 + swz / 64; C = (st & 1) * 32 + (swz % 64) / 2; }
__host__ __device__ __forceinline__ int perm32(int rho) { const int n = rho >> 4, i = rho & 15; return 8 * (i >> 2) + 4 * n + (i & 3); }

struct Unit { const char* A; const char* B; int pm, pn, aux; };
struct Shape { int K, lda, ldb; };

__device__ __forceinline__ void tile_of(int L, int nM, int nN, int& pm, int& pn) {
    const int nwg = nM * nN; int wgid = L;
    { const int q = nwg / 8, r = nwg % 8, xcd = wgid % 8, off = wgid / 8; wgid = (xcd < r ? xcd * (q + 1) : r * (q + 1) + (xcd - r) * q) + off; }
    const int nig = 8 * nN, gid = wgid / nig, fm = gid * 8, gsz = (nM - fm) < 8 ? (nM - fm) : 8;
    pm = fm + ((wgid % nig) % gsz); pn = (wgid % nig) / gsz;
}

template <class Epi, class Sched>
__device__ __forceinline__ void gemm_phase(LAS unsigned char* lds, const Shape g, const Sched& S, const Epi& E, const int tid, const void* base) {
    const int wid = __builtin_amdgcn_readfirstlane(tid >> 6), lane = tid & 63, wr = wid >> 2, wc = wid & 3, fr = lane & 15, fq = lane >> 4;
    const int K = g.K, nt = K / BK;
    const __amdgpu_buffer_rsrc_t rs = __builtin_amdgcn_make_buffer_rsrc((void*)base, 0, 0x7fffffff, 0x00020000);
    unsigned voffA[2], voffB[2];
#pragma unroll
    for (int i = 0; i < 2; ++i) { int R, C; stage_rc(tid * 16 + i * 8192, R, C); const int Rb = Epi::PERM ? ((R & ~31) + perm32(R & 31)) : R;
        voffA[i] = (unsigned)(R * g.lda + C) * 2u; voffB[i] = (unsigned)(Rb * g.ldb + C) * 2u; }
    const unsigned kstep = (unsigned)(BK * 2);
    const unsigned hstepA = (unsigned)HALF * g.lda * 2u, hstepB = (unsigned)HALF * g.ldb * 2u;
    const unsigned ldsw = (unsigned)wid * 1024u;
    const int aoff = lds_byte(wr * 64 + fr, fq * 8), boff = lds_byte(wc * 32 + fr, fq * 8);
#define PG8_SA(b, h) (((b) * 2 + (h)) * HTB)
#define PG8_SB(b, h) ((4 + (b) * 2 + (h)) * HTB)
#define PG8_STAGE(bufoff, goff, voff) do { _Pragma("unroll") for (int _i = 0; _i < 2; ++_i) \
        __builtin_amdgcn_raw_ptr_buffer_load_lds(rs, (LAS void*)(lds + (bufoff) + ldsw + _i * 8192), 16, (voff)[_i], (goff), 0, 0); } while (0)
#define PG8_LDA(dst, b, h) do { _Pragma("unroll") for (int m = 0; m < 4; ++m) _Pragma("unroll") for (int k = 0; k < 2; ++k) dst[m][k] = *(const LAS bf16x8*)(lds + PG8_SA(b, h) + aoff + m * 2048 + k * 1024); } while (0)
#define PG8_LDB(dst, b, h) do { _Pragma("unroll") for (int n = 0; n < 2; ++n) _Pragma("unroll") for (int k = 0; k < 2; ++k) dst[n][k] = *(const LAS bf16x8*)(lds + PG8_SB(b, h) + boff + n * 2048 + k * 1024); } while (0)
#define PG8_MMA(ai, bj, At, Bt) do { __builtin_amdgcn_s_setprio(1); _Pragma("unroll") for (int m = 0; m < 4; ++m) _Pragma("unroll") for (int n = 0; n < 2; ++n) _Pragma("unroll") for (int k = 0; k < 2; ++k) \
        acc[ai][bj][m][n] = __builtin_amdgcn_mfma_f32_16x16x32_bf16(Bt[n][k], At[m][k], acc[ai][bj][m][n], 0, 0, 0); __builtin_amdgcn_s_setprio(0); } while (0)
#define PG8_WAIT_V(n) asm volatile("s_waitcnt vmcnt(" #n ")" ::: "memory")
#define PG8_WAIT_L(n) asm volatile("s_waitcnt lgkmcnt(" #n ")" ::: "memory")
#define PG8_BAR __builtin_amdgcn_s_barrier()
#define PG8_SCHED __builtin_amdgcn_sched_barrier(0)
#define PG8_U32(p_) ((unsigned)__builtin_amdgcn_readfirstlane((int)(unsigned)(size_t)(p_)))
    Unit cur, nxt; int ui = 0;
    if (!S.next(0, cur)) return;
    f32x4 acc[2][2][4][2];
#pragma unroll
    for (int a = 0; a < 2; ++a)
#pragma unroll
        for (int b = 0; b < 2; ++b)
#pragma unroll
            for (int m = 0; m < 4; ++m)
#pragma unroll
                for (int n = 0; n < 2; ++n) acc[a][b][m][n] = (f32x4){0.f, 0.f, 0.f, 0.f};
    bf16x8 At[4][2], B0[2][2], B1[2][2];
    unsigned cA = PG8_U32(cur.A), cB = PG8_U32(cur.B);
    PG8_STAGE(PG8_SB(0, 0), cB, voffB); PG8_STAGE(PG8_SB(0, 1), cB + hstepB, voffB); PG8_STAGE(PG8_SA(0, 0), cA, voffA); PG8_STAGE(PG8_SA(0, 1), cA + hstepA, voffA);
    if (wr == 1) PG8_BAR;
    PG8_WAIT_V(2); PG8_BAR;
    PG8_STAGE(PG8_SB(1, 0), cB + kstep, voffB); PG8_STAGE(PG8_SA(1, 0), cA + kstep, voffA); PG8_STAGE(PG8_SB(1, 1), cB + hstepB + kstep, voffB);
    PG8_WAIT_V(6); PG8_BAR;
    for (;;) {
        const bool has_next = S.next(ui + 1, nxt);
        const unsigned nA = has_next ? PG8_U32(nxt.A) : cA, nB = has_next ? PG8_U32(nxt.B) : cB;
        for (int t = 0; t < nt; t += 2) {
            const bool last = (t == nt - 2);
            const unsigned a1 = cA + (unsigned)(t + 1) * kstep;
            const unsigned a2 = last ? nA : cA + (unsigned)(t + 2) * kstep, b2 = last ? nB : cB + (unsigned)(t + 2) * kstep;
            const unsigned a3 = a2 + kstep, b3 = b2 + kstep;
            PG8_LDB(B0, 0, 0); PG8_LDB(B1, 0, 1); PG8_SCHED; PG8_LDA(At, 0, 0); PG8_STAGE(PG8_SA(1, 1), a1 + hstepA, voffA);
            PG8_WAIT_V(8); PG8_WAIT_L(0); PG8_BAR; PG8_MMA(0, 0, At, B0); PG8_MMA(0, 1, At, B1); PG8_BAR; PG8_SCHED;
            PG8_LDA(At, 0, 1); PG8_STAGE(PG8_SB(0, 0), b2, voffB); PG8_STAGE(PG8_SB(0, 1), b2 + hstepB, voffB); PG8_STAGE(PG8_SA(0, 0), a2, voffA);
            PG8_WAIT_V(8); PG8_WAIT_L(0); PG8_BAR; PG8_MMA(1, 0, At, B0); PG8_MMA(1, 1, At, B1); PG8_BAR; PG8_SCHED;
            PG8_LDB(B0, 1, 0); PG8_LDB(B1, 1, 1); PG8_SCHED; PG8_LDA(At, 1, 0); PG8_STAGE(PG8_SA(0, 1), a2 + hstepA, voffA);
            PG8_WAIT_V(8); PG8_WAIT_L(0); PG8_BAR; PG8_MMA(0, 0, At, B0); PG8_MMA(0, 1, At, B1); PG8_BAR; PG8_SCHED;
            PG8_LDA(At, 1, 1); PG8_STAGE(PG8_SB(1, 0), b3, voffB); PG8_STAGE(PG8_SB(1, 1), b3 + hstepB, voffB); PG8_STAGE(PG8_SA(1, 0), a3, voffA);
            PG8_WAIT_V(8); PG8_WAIT_L(0); PG8_BAR; PG8_MMA(1, 0, At, B0); PG8_MMA(1, 1, At, B1); PG8_BAR; PG8_SCHED;
        }
        if (wr == 0) PG8_BAR;
        E(acc, cur, wr, wc, lds);
        if (!has_next) break;
#pragma unroll
        for (int a = 0; a < 2; ++a)
#pragma unroll
            for (int b = 0; b < 2; ++b)
#pragma unroll
                for (int m = 0; m < 4; ++m)
#pragma unroll
                    for (int n = 0; n < 2; ++n) acc[a][b][m][n] = (f32x4){0.f, 0.f, 0.f, 0.f};
        cur = nxt; cA = nA; cB = nB; ++ui;
        if (wr == 1) PG8_BAR;
    }
    PG8_WAIT_V(0);
    PG8_BAR;
#undef PG8_SA
#undef PG8_SB
#undef PG8_STAGE
#undef PG8_LDA
#undef PG8_LDB
#undef PG8_MMA
#undef PG8_WAIT_V
#undef PG8_WAIT_L
#undef PG8_SCHED
#undef PG8_U32
}

struct EpiBf16 {
    static constexpr bool PERM = true;
    bf16* O0; bf16* O1; int ldc; float scale;
    __device__ __forceinline__ void operator()(const f32x4 (&acc)[2][2][4][2], const Unit& u, int wr, int wc, LAS unsigned char*) const {
        const int lane = fresh_lane(), fr = lane & 15, fq = lane >> 4;
        bf16* O = u.aux ? O1 : O0;
        const int row0 = u.pm * BM + wr * 64 + fr, col0 = u.pn * BM + wc * 32 + 8 * fq;
#pragma unroll
        for (int ai = 0; ai < 2; ++ai)
#pragma unroll
            for (int m = 0; m < 4; ++m) { bf16* rowp = O + (size_t)(row0 + ai * HALF + m * 16) * ldc + col0;
#pragma unroll
                for (int bj = 0; bj < 2; ++bj) { const f32x4 v0 = acc[ai][bj][m][0] * scale, v1 = acc[ai][bj][m][1] * scale;
                    u32x4 w; w.x = pk2(v0[0], v0[1]); w.y = pk2(v0[2], v0[3]); w.z = pk2(v1[0], v1[1]); w.w = pk2(v1[2], v1[3]);
                    *(u32x4*)(rowp + bj * HALF) = w; } }
    }
};
struct EpiProj {
    static constexpr bool PERM = true;
    bf16* P1; bf16* P2;
    __device__ __forceinline__ void operator()(const f32x4 (&acc)[2][2][4][2], const Unit& u, int wr, int wc, LAS unsigned char*) const {
        const int lane = fresh_lane(), fr = lane & 15, fq = lane >> 4;
        const bool second = u.pn >= 10; bf16* O = second ? P2 : P1; const int ldc = second ? 1536 : 2560;
        const int row0 = u.pm * BM + wr * 64 + fr, col0 = (second ? u.pn - 10 : u.pn) * BM + wc * 32 + 8 * fq;
#pragma unroll
        for (int ai = 0; ai < 2; ++ai)
#pragma unroll
            for (int m = 0; m < 4; ++m) { bf16* rowp = O + (size_t)(row0 + ai * HALF + m * 16) * ldc + col0;
#pragma unroll
                for (int bj = 0; bj < 2; ++bj) { const f32x4 v0 = acc[ai][bj][m][0], v1 = acc[ai][bj][m][1];
                    u32x4 w; w.x = pk2(v0[0], v0[1]); w.y = pk2(v0[2], v0[3]); w.z = pk2(v1[0], v1[1]); w.w = pk2(v1[2], v1[3]);
                    *(u32x4*)(rowp + bj * HALF) = w; } }
    }
};
struct EpiSwiGLU {
    static constexpr bool PERM = true;
    bf16* H;
    __device__ __forceinline__ void operator()(const f32x4 (&acc)[2][2][4][2], const Unit& u, int wr, int wc, LAS unsigned char*) const {
        const int lane = fresh_lane(), fr = lane & 15, fq = lane >> 4;
        const int row0 = u.pm * BM + wr * 64 + fr, col0 = u.pn * HALF + wc * 32 + 8 * fq;
#pragma unroll
        for (int ai = 0; ai < 2; ++ai)
#pragma unroll
            for (int m = 0; m < 4; ++m) { bf16* rowp = H + (size_t)(row0 + ai * HALF + m * 16) * DEXP + col0;
                float h[8];
#pragma unroll
                for (int n = 0; n < 2; ++n)
#pragma unroll
                    for (int j = 0; j < 4; ++j) { const float gt = acc[ai][0][m][n][j], up = acc[ai][1][m][n][j]; h[n * 4 + j] = gt * sigmoidf_(gt) * up; }
                u32x4 w; w.x = pk2(h[0], h[1]); w.y = pk2(h[2], h[3]); w.z = pk2(h[4], h[5]); w.w = pk2(h[6], h[7]);
                *(u32x4*)rowp = w; }
    }
};
struct EpiSoftmax {
    static constexpr bool PERM = true;
    bf16* P;
    __device__ __forceinline__ void operator()(f32x4 (&acc)[2][2][4][2], const Unit& u, int wr, int wc, LAS unsigned char* lds) const {
        const int lane = fresh_lane(), fr = lane & 15, fq = lane >> 4;
        LAS float* PM = (LAS float*)(lds + EPI_OFF);
        LAS float* PS = (LAS float*)(lds + EPI_OFF + 4096);
        float mx[2][4];
#pragma unroll
        for (int ai = 0; ai < 2; ++ai)
#pragma unroll
            for (int m = 0; m < 4; ++m) { float v = -3.0e38f;
#pragma unroll
                for (int bj = 0; bj < 2; ++bj)
#pragma unroll
                    for (int n = 0; n < 2; ++n)
#pragma unroll
                        for (int j = 0; j < 4; ++j) v = fmaxf(v, acc[ai][bj][m][n][j]);
                v = fmaxf(v, shx(v, 16, lane)); v = fmaxf(v, shx(v, 32, lane));
                if (fq == 0) PM[(ai * HALF + wr * 64 + m * 16 + fr) * 4 + wc] = v; }
        LDS_WAIT(); __builtin_amdgcn_s_barrier(); asm volatile("" ::: "memory");
#pragma unroll
        for (int ai = 0; ai < 2; ++ai)
#pragma unroll
            for (int m = 0; m < 4; ++m) { const f32x4 pm4 = *(const LAS f32x4*)(PM + (ai * HALF + wr * 64 + m * 16 + fr) * 4);
                const float rm = fmaxf(fmaxf(pm4[0], pm4[1]), fmaxf(pm4[2], pm4[3])); float s = 0.f;
#pragma unroll
                for (int bj = 0; bj < 2; ++bj)
#pragma unroll
                    for (int n = 0; n < 2; ++n)
#pragma unroll
                        for (int j = 0; j < 4; ++j) { const float ev = __expf(acc[ai][bj][m][n][j] - rm); acc[ai][bj][m][n][j] = ev; s += ev; }
                s += shx(s, 16, lane); s += shx(s, 32, lane);
                if (fq == 0) PS[(ai * HALF + wr * 64 + m * 16 + fr) * 4 + wc] = s; }
        LDS_WAIT(); __builtin_amdgcn_s_barrier(); asm volatile("" ::: "memory");
        const int row0 = u.pm * BM + wr * 64 + fr, col0 = u.pn * BM + wc * 32 + 8 * fq;
#pragma unroll
        for (int ai = 0; ai < 2; ++ai)
#pragma unroll
            for (int m = 0; m < 4; ++m) { const f32x4 ps4 = *(const LAS f32x4*)(PS + (ai * HALF + wr * 64 + m * 16 + fr) * 4);
                const float inv = 1.0f / ((ps4[0] + ps4[1]) + (ps4[2] + ps4[3]));
                bf16* rowp = P + (size_t)(row0 + ai * HALF + m * 16) * D + col0;
#pragma unroll
                for (int bj = 0; bj < 2; ++bj) { const f32x4 v0 = acc[ai][bj][m][0] * inv, v1 = acc[ai][bj][m][1] * inv; u32x4 w;
                    w.x = pk2(v0[0], v0[1]); w.y = pk2(v0[2], v0[3]); w.z = pk2(v1[0], v1[1]); w.w = pk2(v1[2], v1[3]);
                    *(u32x4*)(rowp + bj * HALF) = w; } }
    }
};
}

#define XB_TMO      128
#define XB_XCNT(j)  (256  + 64 * (j))
#define XB_XSUB(j)  (1280 + 64 * (j))
#define XB_XGEN(j)  (2304 + 64 * (j))
#define XB_TOP      3328
#define XB_TOPGEN   3392
#define XCD_BAR_WORDS 3456
#define XB_SPIN_CAP (1u << 22)
__device__ __forceinline__ unsigned xb_ld(unsigned* p)              { return __hip_atomic_load(p, __ATOMIC_RELAXED, __HIP_MEMORY_SCOPE_AGENT); }
__device__ __forceinline__ unsigned xb_add(unsigned* p, unsigned v) { return __hip_atomic_fetch_add(p, v, __ATOMIC_RELAXED, __HIP_MEMORY_SCOPE_AGENT); }
__device__ __forceinline__ unsigned xb_xcc_id() { return (unsigned)__builtin_amdgcn_s_getreg((3 << 11) | 20) & 0xFu; }
#define XB_SPIN(cond, bar) do { unsigned _sp = 0; while (cond) { __builtin_amdgcn_s_sleep(1); \
    if ((++_sp & 255u) == 0u) { if (xb_ld(&(bar)[XB_TMO])) break; if (_sp > XB_SPIN_CAP) { atomicAdd(&(bar)[XB_TMO], 1u); break; } } } } while (0)
struct XcdBarrier { unsigned* bar; unsigned x; volatile LAS unsigned* st; };
__device__ __forceinline__ XcdBarrier xcd_barrier_post(unsigned* bar, volatile LAS unsigned* st, int tid) {
    XcdBarrier b; b.bar = bar; b.x = xb_xcc_id(); b.st = st;
    if (tid == 0) (void)xb_add(&bar[XB_XCNT(b.x)], 1u);
    return b;
}
__device__ __forceinline__ void xcd_barrier_complete(unsigned* bar, unsigned x, unsigned& nloc, unsigned& nx) {
    const unsigned G = gridDim.x * gridDim.y * gridDim.z;
    unsigned sum, cnt, mine, sp = 0u;
    for (;;) {
        sum = 0u; cnt = 0u; mine = 0u;
#pragma unroll
        for (unsigned j = 0; j < 16; ++j) { const unsigned c = xb_ld(&bar[XB_XCNT(j)]); sum += c; cnt += (c > 0u) ? 1u : 0u; mine = (j == x) ? c : mine; }
        if (sum == G) break;
        __builtin_amdgcn_s_sleep(1);
        if ((++sp & 255u) == 0u) { if (xb_ld(&bar[XB_TMO])) break; if (sp > XB_SPIN_CAP) { atomicAdd(&bar[XB_TMO], 1u); break; } }
    }
    nloc = mine > 0u ? mine : 1u; nx = cnt > 0u ? cnt : 1u;
}
__device__ __forceinline__ void xcd_barrier(const XcdBarrier& b, int tid) {
    asm volatile("s_waitcnt vmcnt(0)" ::: "memory");
    __syncthreads();
    if (tid == 0) {
        unsigned* bar = b.bar;
        __builtin_amdgcn_s_waitcnt(0);
        unsigned nloc = b.st[0], nx = b.st[1];
        if (nloc == 0u) { xcd_barrier_complete(bar, b.x, nloc, nx); b.st[0] = nloc; b.st[1] = nx; }
        const unsigned old = xb_add(&bar[XB_XSUB(b.x)], 1u);
        const unsigned gen = old / nloc;
        if (old + 1u == (gen + 1u) * nloc) {
            __builtin_amdgcn_fence(__ATOMIC_RELEASE, "agent");
            asm volatile("s_waitcnt vmcnt(0)" ::: "memory");
            const unsigned og = xb_add(&bar[XB_TOP], 1u);
            const unsigned tg = og / nx;
            if (og + 1u == (tg + 1u) * nx) xb_add(&bar[XB_TOPGEN], 1u);
            else XB_SPIN(xb_ld(&bar[XB_TOPGEN]) == tg, bar);
            __builtin_amdgcn_fence(__ATOMIC_ACQUIRE, "agent");
            xb_add(&bar[XB_XGEN(b.x)], 1u);
            asm volatile("s_waitcnt vmcnt(0)" ::: "memory");
        } else {
            XB_SPIN(xb_ld(&bar[XB_XGEN(b.x)]) == gen, bar);
            __builtin_amdgcn_fence(__ATOMIC_ACQUIRE, "agent");
            asm volatile("s_waitcnt vmcnt(0)" ::: "memory");
        }
    }
    __syncthreads();
}

struct Params { const float* in[25]; float* out; unsigned char* ws; int ph_lo, ph_hi; };
enum { I_X = 0, I_MEM, I_WIN, I_LBL, I_HGNW, I_CONVW, I_ALOG, I_DTB, I_GDNW, I_WOUT, I_MLNG, I_MLNB, I_WMQ, I_WMK, I_WMV, I_WMO, I_WGRP, I_BGRP, I_WRT, I_BRT, I_WGATE, I_WUP, I_WDOWN, I_LNG, I_LNB };
constexpr int PH_PRO = 0, PH_KV = 1, PH_L0 = 2, PH_PER_LAYER = 16, N_PHASES = PH_L0 + DEPTH * PH_PER_LAYER;

typedef const __attribute__((address_space(4))) Params* KParams;
struct Ctx { LAS unsigned char* lds; unsigned char* ws; KParams p; int tid, lane, wave, gw, ngw, G, bid; };

__device__ __forceinline__ void transpose_item(const float* W, int ldw, int src_col0, int K, bf16* WT, int dst_row0, LAS float* scr, int k0, int lane) {
    float rv[32];
#pragma unroll
    for (int i = 0; i < 32; ++i) { const int kk = 2 * i + (lane >> 5); rv[i] = W[(size_t)(k0 + kk) * ldw + src_col0 + (lane & 31)]; }
#pragma unroll
    for (int i = 0; i < 32; ++i) { const int kk = 2 * i + (lane >> 5); scr[kk * 33 + (lane & 31)] = rv[i]; }
    LDS_WAIT(); asm volatile("" ::: "memory");
    const int c = lane & 7;
#pragma unroll
    for (int j = 0; j < 4; ++j) { const int n = (lane >> 3) + 8 * j; const LAS float* s = scr + (8 * c) * 33 + n;
        u32x4 o; o.x = pk2(s[0 * 33], s[1 * 33]); o.y = pk2(s[2 * 33], s[3 * 33]); o.z = pk2(s[4 * 33], s[5 * 33]); o.w = pk2(s[6 * 33], s[7 * 33]);
        *(u32x4*)(WT + (size_t)(dst_row0 + n) * K + k0 + 8 * c) = o; }
    LDS_WAIT(); asm volatile("" ::: "memory");
}

__device__ __forceinline__ void convert_item(const float* W, int ldw, int src_col0, int K, bf16* WT, int dst_row0, int k0, int lane) {
    const int kh = lane >> 5, nq = lane & 31;
    const float* src = W + (size_t)(k0 + 8 * kh) * ldw + src_col0 + 4 * nq; bf16* dst = WT + (size_t)(dst_row0 + 4 * nq) * K + k0 + 8 * kh;
#pragma unroll
    for (int s2 = 0; s2 < 2; ++s2) { f32x4 v[2][8];
#pragma unroll
        for (int s = 0; s < 2; ++s)
#pragma unroll
            for (int j = 0; j < 8; ++j) v[s][j] = *(const f32x4*)(src + (size_t)(32 * s2 + 16 * s + j) * ldw);
#pragma unroll
        for (int s = 0; s < 2; ++s)
#pragma unroll
            for (int q = 0; q < 4; ++q) { u32x4 o; o.x = pk2(v[s][0][q], v[s][1][q]); o.y = pk2(v[s][2][q], v[s][3][q]); o.z = pk2(v[s][4][q], v[s][5][q]); o.w = pk2(v[s][6][q], v[s][7][q]);
                *(u32x4*)(dst + (size_t)q * K + 32 * s2 + 16 * s) = o; } }
}

__device__ __forceinline__ void stage_wab(const Ctx& C, LAS float* wl, int lg) {
    const float* src = C.p->in[I_WIN] + (size_t)lg * D * INW + 3584;
    for (int i = C.tid; i < 8 * D; i += 512) { const int k = i >> 3, o = i & 7; wl[o * D + k] = src[(size_t)k * INW + o]; }
}
__device__ __forceinline__ void gb_row(const Ctx& C, const f32x4 (&y)[4], const LAS float* wl, int lg, size_t tok) {
    float dots[8];
#pragma unroll
    for (int o = 0; o < 8; ++o) { float sacc = 0.f;
#pragma unroll
        for (int j = 0; j < 4; ++j) { const f32x4 wv = *(const LAS f32x4*)(wl + o * D + 4 * (C.lane + 64 * j)); sacc += (y[j][0] * wv[0] + y[j][1] * wv[1]) + (y[j][2] * wv[2] + y[j][3] * wv[3]); }
        dots[o] = sacc; }
#pragma unroll
    for (int o = 0; o < 8; ++o) dots[o] = row16_sum(dots[o]);
#pragma unroll
    for (int o = 0; o < 8; ++o) dots[o] += shx(dots[o], 16, C.lane);
#pragma unroll
    for (int o = 0; o < 8; ++o) dots[o] += shx(dots[o], 32, C.lane);
    if (C.lane < 4) { const int h = C.lane; float ga = 0.f, gb = 0.f;
#pragma unroll
        for (int o = 0; o < 4; ++o) { ga = (h == o) ? dots[o] : ga; gb = (h == o) ? dots[4 + o] : gb; }
        const float z = ga + C.p->in[I_DTB][lg * 4 + h]; const float sp = fmaxf(z, 0.f) + log1pf(expf(-fabsf(z)));
        ((float*)(C.ws + WS_G))[tok * 4 + h] = -expf(C.p->in[I_ALOG][lg * 4 + h]) * sp;
        ((float*)(C.ws + WS_G + G_BETA))[tok * 4 + h] = 1.0f / (1.0f + expf(-gb)); }
}

__device__ __forceinline__ void phase_prologue(const Ctx& C) {
    KParams pp_ = C.p; const auto& p = *pp_; unsigned char* ws = C.ws;
    constexpr int IT_WIN = DEPTH * 16 * 32, IT_SQ = DEPTH * 16 * 8;
    constexpr int NIT = IT_WIN + 5 * IT_SQ;
    for (int it = C.gw; it < NIT; it += C.ngw) {
        int r = it;
        if (r < IT_WIN) { const int l = r / (16 * 32), q = r % (16 * 32), kb = q / 32, nb = q % 32; const int n0 = nb * 128, src = n0 < 2048 ? n0 : (n0 < 2560 ? n0 + 1544 : n0 - 512);
            convert_item(p.in[I_WIN] + (size_t)l * D * INW, INW, src, D, (bf16*)(ws + WS_W_IN) + (size_t)l * PW * D, n0, kb * 64, C.lane); continue; }
        r -= IT_WIN;
        const int mat = r / IT_SQ, q2 = r % IT_SQ, l = q2 / 128, q = q2 % 128, kb = q / 8, nb = q % 8;
        const float* src; bf16* dst;
        if (mat == 0) { src = p.in[I_WOUT]; dst = (bf16*)(ws + WS_W_OUT); } else if (mat == 1) { src = p.in[I_WMQ]; dst = (bf16*)(ws + WS_W_Q); }
        else if (mat == 2) { src = p.in[I_WMO]; dst = (bf16*)(ws + WS_W_O); } else if (mat == 3) { src = p.in[I_WMK]; dst = (bf16*)(ws + WS_W_K); }
        else { src = p.in[I_WMV]; dst = (bf16*)(ws + WS_W_V); }
        convert_item(src + (size_t)l * D * D, D, nb * 128, D, dst + (size_t)l * D * D, nb * 128, kb * 64, C.lane);
    }
    LAS float* wl = (LAS float*)(C.lds + 123904);
    stage_wab(C, wl, 0);
    __syncthreads();
    for (int m = C.gw; m < NTOK; m += C.ngw) {
        const f32x4* xr = (const f32x4*)(p.in[I_X] + (size_t)m * D) + C.lane; f32x4* xo = (f32x4*)((float*)(ws + WS_X) + (size_t)m * D) + C.lane;
        u32x2* xb = (u32x2*)((bf16*)(ws + WS_XN) + (size_t)m * D) + C.lane; f32x4 v[4];
#pragma unroll
        for (int j = 0; j < 4; ++j) { v[j] = xr[64 * j]; xo[64 * j] = v[j]; u32x2 w; w.x = pk2(v[j][0], v[j][1]); w.y = pk2(v[j][2], v[j][3]); xb[64 * j] = w; }
        gb_row(C, v, wl, 0, (size_t)m);
    }
    for (int m = C.gw; m < NMEM; m += C.ngw) {
        const f32x4* xr = (const f32x4*)(p.in[I_MEM] + (size_t)m * D) + C.lane; f32x4 v[4]; float s = 0.f;
#pragma unroll
        for (int j = 0; j < 4; ++j) { v[j] = xr[64 * j]; s += (v[j][0] + v[j][1]) + (v[j][2] + v[j][3]); }
        const float mean = wave_sum(s, C.lane) * (1.f / D); float s2 = 0.f;
#pragma unroll
        for (int j = 0; j < 4; ++j) { v[j] = v[j] - mean; s2 += (v[j][0] * v[j][0] + v[j][1] * v[j][1]) + (v[j][2] * v[j][2] + v[j][3] * v[j][3]); }
        const float rstd = __builtin_amdgcn_rsqf(wave_sum(s2, C.lane) * (1.f / D) + LN_EPS);
        u32x2* xb = (u32x2*)((bf16*)(ws + WS_MEMN) + (size_t)m * D) + C.lane;
#pragma unroll
        for (int j = 0; j < 4; ++j) { const f32x4 g = ((const f32x4*)p.in[I_MLNG])[C.lane + 64 * j], b = ((const f32x4*)p.in[I_MLNB])[C.lane + 64 * j]; const f32x4 y = v[j] * rstd * g + b;
            u32x2 w; w.x = pk2(y[0], y[1]); w.y = pk2(y[2], y[3]); xb[64 * j] = w; }
    }
    { float* lb = (float*)(ws + WS_SMALL + SM_LB);
      for (int c = C.bid * 512 + C.tid; c < 512; c += C.G * 512) { float z[DEPTH], mx = -3e38f; for (int l = 0; l < DEPTH; ++l) { z[l] = p.in[I_LBL][l * 512 + c]; mx = fmaxf(mx, z[l]); }
          float s = 0.f; for (int l = 0; l < DEPTH; ++l) { z[l] = expf(z[l] - mx); s += z[l]; }
          float cum = 0.f; for (int l = 0; l < DEPTH; ++l) { if (l > 0) cum += z[l] / s; lb[l * 512 + c] = cum; } } }
}

__device__ __forceinline__ void convert_experts(const Ctx& C, int l) {
    KParams pp_ = C.p; const auto& p = *pp_;
    constexpr int IT_G = NEXP * 16 * 4, IT_D = NEXP * 8 * 8;
    for (int it = C.gw; it < 2 * IT_G + IT_D; it += C.ngw) {
        if (it < 2 * IT_G) { const int s = it / IT_G, r = it % IT_G, e = r / 64, q = r % 64, kb = q / 4, nb = q % 4;
            const float* src = p.in[s ? I_WUP : I_WGATE] + ((size_t)l * NEXP + e) * D * DEXP;
            convert_item(src, DEXP, nb * 128, D, (bf16*)(C.ws + WS_GU) + (size_t)e * D * D, 256 * nb + 128 * s, kb * 64, C.lane); }
        else { const int r = it - 2 * IT_G, e = r / 64, q = r % 64, kb = q / 8, nb = q % 8;
            convert_item(p.in[I_WDOWN] + ((size_t)l * NEXP + e) * DEXP * D, D, nb * 128, DEXP, (bf16*)(C.ws + WS_DN) + (size_t)e * D * DEXP, nb * 128, kb * 64, C.lane); }
    }
}

struct SchedDense {
    const char* A; const char* B; int nM, nN, lda, ldb, G, c;
    __device__ __forceinline__ bool next(int i, pg8::Unit& u) const {
        const long L = (long)i * G + c; if (L >= (long)nM * nN) return false;
        int pm, pn; pg8::tile_of((int)L, nM, nN, pm, pn);
        u.pm = pm; u.pn = pn; u.aux = 0; u.A = A + (size_t)pm * 256 * lda * 2; u.B = B + (size_t)pn * 256 * ldb * 2; return true; }
};
struct SchedKV {
    const char* memn; const char* wk; const char* wv; int G, c;
    __device__ __forceinline__ bool next(int i, pg8::Unit& u) const {
        const long L = (long)i * G + c; if (L >= 512) return false;
        const int which = (int)L >> 8; int pm, pn; pg8::tile_of((int)L & 255, 16, 16, pm, pn);
        u.pm = pm; u.pn = pn; u.aux = which;
        u.A = (which ? wv : memn) + (size_t)pm * 256 * D * 2; u.B = (which ? memn : wk) + (size_t)pn * 256 * D * 2; return true; }
};
struct SchedAttn {
    const char* A; const char* B; int pv, l, G, c;
    __device__ __forceinline__ bool next(int i, pg8::Unit& u) const {
        const int L = i * G + c; if (L >= 512) return false;
        const int pm = L >> 2, h = L & 3, b = pm >> 3;
        u.pm = pm; u.pn = h; u.aux = 0; u.A = A + ((size_t)pm * 256 * D + h * 256) * 2; u.B = B + ((size_t)b * 256 * 4096 + l * D + h * 256) * 2; return true; }
};
struct SchedAttnPV {
    const char* A; const char* B; int l, G, c;
    __device__ __forceinline__ bool next(int i, pg8::Unit& u) const {
        const int L = i * G + c; if (L >= 512) return false;
        const int pm = L >> 2, h = L & 3, b = pm >> 3;
        u.pm = pm; u.pn = h; u.aux = 0; u.A = A + ((size_t)pm * 256 * D + h * 256) * 2; u.B = B + (((size_t)l * D + h * 256) * 4096 + b * 256) * 2; return true; }
};
struct SchedMoE {
    const char* A; const char* B; const int* tile_tab; int ntiles, lda, ldb, G, c;
    __device__ __forceinline__ bool next(int i, pg8::Unit& u) const {
        const long L = (long)i * G + c; if (L >= (long)ntiles * 4) return false;
        int pm, pn; pg8::tile_of((int)L, ntiles, 4, pm, pn); const int e = __builtin_amdgcn_readfirstlane(tile_tab[16 + pm]);
        u.pm = pm; u.pn = pn; u.aux = 0; u.A = A + (size_t)pm * 256 * lda * 2; u.B = B + ((size_t)e * 1024 + pn * 256) * ldb * 2; return true; }
};

__device__ __forceinline__ int img_off(int r, int c, int KS) { const int rr = r & 15, pp = pg8::perm32(c & 31); return ((r >> 4) * KS + (c >> 5)) * 1024 + ((rr * 64 + pp * 2) ^ ((rr >> 3) << 5)); }
__device__ __forceinline__ int u_idx(int t, int v) { return (((v >> 4) * 64 + ((t & 15) >> 2) * 16 + (v & 15)) * 4 + (t >> 4)) * 4 + (t & 3); }
__device__ __forceinline__ f32x4 mfma16(bf16x8 a, bf16x8 b, f32x4 c) { return __builtin_amdgcn_mfma_f32_16x16x32_bf16(a, b, c, 0, 0, 0); }
constexpr int RP = 136;
__device__ __forceinline__ f32x4 score_tile(const LAS bf16* X, const LAS bf16* Y, int mt, int nt, int lane) {
    const int rr = lane & 15, g = lane >> 4; f32x4 acc = (f32x4){0.f, 0.f, 0.f, 0.f};
#pragma unroll
    for (int kk = 0; kk < 4; ++kk) { const bf16x8 a = *(const LAS bf16x8*)(X + (16 * mt + rr) * RP + 32 * kk + 8 * g), b = *(const LAS bf16x8*)(Y + (16 * nt + rr) * RP + 32 * kk + 8 * g); acc = mfma16(a, b, acc); }
    return acc;
}
__device__ __forceinline__ void copy_record(const Ctx& C, unsigned char* dst, int bytes) {
    const int np = bytes / 16;
    for (int i0 = C.tid; i0 < np; i0 += 2048) { u32x4 t[4];
#pragma unroll
        for (int q = 0; q < 4; ++q) if (i0 + 512 * q < np) t[q] = ((const LAS u32x4*)C.lds)[i0 + 512 * q];
#pragma unroll
        for (int q = 0; q < 4; ++q) if (i0 + 512 * q < np) ((u32x4*)dst)[i0 + 512 * q] = t[q]; }
}
__device__ __forceinline__ unsigned char* rech_ptr(unsigned char* ws, int b, int h, int n) { return ws + (b < 8 ? WS_RECH0 : WS_RECH1) + ((size_t)((b & 7) * 4 + h) * 32 + n) * REC_H; }

struct R1Pre { u32x4 r[7]; f32x4 cwv; float gv, bv; };
__device__ __forceinline__ void r1_prefetch(const Ctx& C, int l, int item, R1Pre& P) {
    const int gd = item < 2048, q0 = item & 2047, b = q0 >> 7, h = (q0 >> 5) & 3, n = q0 & 31; const size_t tok0 = (size_t)b * T + n * 64;
    if (gd) { const bf16* PROJ = (const bf16*)(C.ws + WS_PROJ2);
#pragma unroll
        for (int i = 0; i < 7; ++i) { const int idx = C.tid + 512 * i; P.r[i] = (u32x4){0u, 0u, 0u, 0u};
            if (idx < 3216) { const int ty = idx / 1072, q = idx - ty * 1072, rw = q >> 4, pc = q & 15; if (n > 0 || rw >= 3) P.r[i] = *(const GAS u32x4*)(PROJ + (tok0 + rw - 3) * P2W + ty * 512 + h * 128 + pc * 8); } }
        if (C.tid < 384) { const int ty = C.tid >> 7, r_ = C.tid & 127, k = r_ >> 5, c4 = r_ & 31; P.cwv = *(const GAS f32x4*)(C.p->in[I_CONVW] + ((size_t)l * 4 + k) * 1536 + ty * 512 + h * 128 + c4 * 4); }
        if (C.wave == 7) { P.gv = ((const GAS float*)(C.ws + WS_G))[(tok0 + C.lane) * 4 + h]; P.bv = ((const GAS float*)(C.ws + WS_G + G_BETA))[(tok0 + C.lane) * 4 + h]; }
    } else { const bf16* PROJ = (const bf16*)(C.ws + WS_PROJ1);
#pragma unroll
        for (int i = 0; i < 6; ++i) { const int idx = C.tid + 512 * (i & 1), t = idx >> 4, pc = idx & 15, ty = i >> 1; P.r[i] = *(const GAS u32x4*)(PROJ + (tok0 + t) * P1W + ty * 512 + h * 128 + pc * 8); }
    }
}

__device__ __forceinline__ void r1_hgrn2(const Ctx& C0, int l, int b, int h, int n, R1Pre& P, int next_item) {
    Ctx C = C0; { int t_ = C0.tid; asm volatile("" : "+v"(t_)); C.tid = t_; C.lane = t_ & 63; }
    constexpr int O_KT = 16384, O_QK = 32768, O_E = 40960, O_U = 41984, LQ = 59392, LK = LQ + 17408, LS = LK + 17408, LR = LS + 2048;
    LAS unsigned char* L = C.lds; LAS bf16* Qs = (LAS bf16*)(L + LQ); LAS bf16* Ks = (LAS bf16*)(L + LK); LAS float* segt = (LAS float*)(L + LS); LAS bf16* Rw = (LAS bf16*)(L + LR);
    asm volatile("" : "+v"(Qs), "+v"(Ks), "+v"(segt), "+v"(L), "+v"(Rw));
    const int d = C.tid & 127, seg = C.tid >> 7;
#pragma unroll
    for (int i = 0; i < 6; ++i) { const int idx = C.tid + 512 * (i & 1), ty = i >> 1; *(LAS u32x4*)(Rw + ty * 8192 + idx * 8) = P.r[i]; }
    if (next_item < 4096) r1_prefetch(C, l, next_item, P);
    const float lb = ((const float*)(C.ws + WS_SMALL + SM_LB))[l * 512 + h * 128 + d];
    __syncthreads();
    float run = 0.f;
#pragma unroll
    for (int i4 = 0; i4 < 4; ++i4) { unsigned uv[4];
#pragma unroll
        for (int e = 0; e < 4; ++e) { const int t = 16 * seg + 4 * i4 + e; const float z = bf2f(Rw[8192 + t * 128 + d]);
            const float f = lb + (1.f - lb) * sigmoidf_(z); run += __logf(f); uv[e] = Rw[16384 + t * 128 + d]; }
        u32x2 w2; w2.x = uv[0] | (uv[1] << 16); w2.y = uv[2] | (uv[3] << 16);
        *(LAS u32x2*)(L + O_U + 2 * ((((d >> 4) * 64 + i4 * 16 + (d & 15)) * 4 + seg) * 4)) = w2; }
    segt[seg * 128 + d] = run;
    __syncthreads();
    const float s0 = segt[d], s1 = segt[128 + d], s2 = segt[256 + d], s3 = segt[384 + d];
    const float prefix = seg == 0 ? 0.f : seg == 1 ? s0 : seg == 2 ? s0 + s1 : (s0 + s1) + s2, ref = s0 + s1, last = (s0 + s1) + (s2 + s3);
    float c = prefix;
#pragma unroll
    for (int i4 = 0; i4 < 4; ++i4) { float kt[4];
#pragma unroll
        for (int e = 0; e < 4; ++e) { const int t = 16 * seg + 4 * i4 + e; const float qv = bf2f(Rw[t * 128 + d]), z = bf2f(Rw[8192 + t * 128 + d]);
            const float sg = sigmoidf_(z), f = lb + (1.f - lb) * sg, kv = (1.f - lb) * (1.f - sg); c += __logf(f);
            Qs[t * RP + d] = (bf16)f2bf(qv * __expf(c - ref)); Ks[t * RP + d] = (bf16)f2bf(kv * __expf(ref - c));
            *(LAS bf16*)(L + img_off(t, d, 4)) = (bf16)f2bf(qv * __expf(c)); kt[e] = kv * __expf(last - c); }
        u32x2 w2; w2.x = pk2(kt[0], kt[1]); w2.y = pk2(kt[2], kt[3]);
        *(LAS u32x2*)(L + O_KT + ((d >> 4) * 2 + (seg >> 1)) * 1024 + (((d & 15) * 64 + 16 * i4 + 8 * (seg & 1)) ^ (((d & 15) >> 3) << 5))) = w2; }
    if (seg == 0) *(LAS float*)(L + O_E + 4 * d) = __expf(last);
    if (seg == 1) *(LAS float*)(L + O_E + 512 + 4 * d) = 0.f;
    __syncthreads();
#pragma unroll
    for (int jj = 0; jj < 2; ++jj) { const int job = C.wave + 8 * jj, mt = job >> 2, nt = job & 3, rr = C.lane & 15, g = C.lane >> 4;
        f32x4 acc = (f32x4){0.f, 0.f, 0.f, 0.f};
        if (nt <= mt) acc = score_tile(Qs, Ks, mt, nt, C.lane);
#pragma unroll
        for (int r = 0; r < 4; ++r) { const int t = 16 * mt + 4 * g + r, sx = 16 * nt + rr; *(LAS bf16*)(L + O_QK + img_off(t, sx, 2)) = (bf16)f2bf((nt <= mt && sx <= t) ? acc[r] : 0.f); } }
    __syncthreads();
    copy_record(C, rech_ptr(C.ws, b, h, n), REC_H);
    __syncthreads();
}

typedef short bf16x4 __attribute__((ext_vector_type(4)));
__device__ __forceinline__ f32x4 mfma16k16(bf16x4 a, bf16x4 b, f32x4 c) { return __builtin_amdgcn_mfma_f32_16x16x16bf16_1k(a, b, c, 0, 0, 0); }
__device__ __forceinline__ bf16x4 pack4(f32x4 v) { u32x2 w; w.x = pk2(v[0], v[1]); w.y = pk2(v[2], v[3]); return __builtin_bit_cast(bf16x4, w); }
template <int B> __device__ __forceinline__ void inv_rows4(float (&t)[16], const LAS float* Ab, int c) {
    f32x4 av[4][B + 1];
#pragma unroll
    for (int i = 0; i < 4; ++i)
#pragma unroll
        for (int q = 0; q <= B; ++q) av[i][q] = *(const LAS f32x4*)(Ab + (4 * B + i) * 64 + 4 * q);
#pragma unroll
    for (int i = 0; i < 4; ++i) { const int r = 4 * B + i; float a = (r == c) ? 1.f : 0.f;
#pragma unroll
        for (int q = 0; q <= B; ++q)
#pragma unroll
            for (int e = 0; e < 4; ++e) if (4 * q + e < r) a -= av[i][q][e] * t[4 * q + e];
        t[r] = a; }
}

__device__ __forceinline__ void r1_gdn(const Ctx& C0, int l, int b, int h, int n, R1Pre& P, int next_item) {
    Ctx C = C0; { int t_ = C0.tid; asm volatile("" : "+v"(t_)); C.tid = t_; C.lane = t_ & 63; }
    constexpr int O_KT = 32768, O_QK = 49152, O_E = 57344, O_U = 58368;
    constexpr int LQ = 59392, LK = 76800, LRT = 94208, LA = 131072, LTB = 147456, LC = 156672, RAWB = 17152, RTP = 72, TBP = 72;
    LAS unsigned char* L = C.lds; LAS bf16* Qs = (LAS bf16*)(L + LQ); LAS bf16* Ks = (LAS bf16*)(L + LK); LAS bf16* RT = (LAS bf16*)(L + LRT); LAS float* Am = (LAS float*)(L + LA);
    LAS bf16* Tb = (LAS bf16*)(L + LTB); LAS float* cs = (LAS float*)(L + LC); LAS float* cw = (LAS float*)(L + LA);
    asm volatile("" : "+v"(Qs), "+v"(Ks), "+v"(RT), "+v"(Am), "+v"(Tb), "+v"(cs), "+v"(L), "+v"(cw));
    LAS float* ec = cs + 64; LAS float* bt = cs + 128;
    unsigned char* rec = C.ws + WS_RECG + ((size_t)(b * 4 + h) * 32 + n) * REC_G;
    const int rr = C.lane & 15, g = C.lane >> 4;
#pragma unroll
    for (int i = 0; i < 7; ++i) { const int idx = C.tid + 512 * i; if (idx < 3216) { const int ty = idx / 1072, q = idx - ty * 1072; *(LAS u32x4*)(L + ty * RAWB + q * 16) = P.r[i]; } }
    if (C.tid < 384) { const int ty = C.tid >> 7, r_ = C.tid & 127, k = r_ >> 5, c4 = r_ & 31; *(LAS f32x4*)(cw + (ty * 4 + k) * 128 + c4 * 4) = P.cwv; }
    if (C.wave == 7) { float c = P.gv;
#pragma unroll
        for (int o = 1; o < 64; o <<= 1) { const float up = __builtin_bit_cast(float, __builtin_amdgcn_ds_bpermute(((C.lane - o) & 63) << 2, __builtin_bit_cast(int, c))); if (C.lane >= o) c += up; }
        cs[C.lane] = c; ec[C.lane] = __expf(c); bt[C.lane] = P.bv; }
    if (next_item < 4096) r1_prefetch(C, l, next_item, P);
    __syncthreads();
    { const int t = C.tid >> 3, cg = C.tid & 7; const float btt = bt[t], bet = bt[t] * ec[t];
#pragma unroll
      for (int ty = 0; ty < 3; ++ty) { float y[16];
#pragma unroll
          for (int e = 0; e < 16; ++e) y[e] = 0.f;
          u32x4 xr0[4], xr1[4]; f32x4 wv[4][4];
#pragma unroll
          for (int k = 0; k < 4; ++k) { const LAS unsigned char* rp = L + ty * RAWB + (t + k) * 256 + cg * 32; xr0[k] = *(const LAS u32x4*)rp; xr1[k] = *(const LAS u32x4*)(rp + 16);
#pragma unroll
              for (int e4 = 0; e4 < 4; ++e4) wv[k][e4] = *(const LAS f32x4*)(cw + (ty * 4 + k) * 128 + cg * 16 + e4 * 4); }
          __builtin_amdgcn_sched_barrier(0);
#pragma unroll
          for (int k = 0; k < 4; ++k) { const unsigned xw[8] = {xr0[k].x, xr0[k].y, xr0[k].z, xr0[k].w, xr1[k].x, xr1[k].y, xr1[k].z, xr1[k].w};
#pragma unroll
              for (int e4 = 0; e4 < 4; ++e4) { const f32x4 w4 = wv[k][e4];
                  y[4 * e4] += w4[0] * bflo(xw[2 * e4]); y[4 * e4 + 1] += w4[1] * bfhi(xw[2 * e4]); y[4 * e4 + 2] += w4[2] * bflo(xw[2 * e4 + 1]); y[4 * e4 + 3] += w4[3] * bfhi(xw[2 * e4 + 1]); } }
          float ss = 0.f;
#pragma unroll
          for (int e = 0; e < 16; ++e) { y[e] = y[e] * sigmoidf_(y[e]); ss += y[e] * y[e]; }
          if (ty < 2) { ss += shx(ss, 1, C.lane); ss += shx(ss, 2, C.lane); ss += shx(ss, 4, C.lane); float rn = __builtin_amdgcn_rsqf(ss + L2_EPS); if (ty == 0) rn *= 0.08838834764831845f;
#pragma unroll
              for (int e = 0; e < 16; ++e) y[e] *= rn; }
          if (ty < 2) { u32x4 o0, o1; o0.x = pk2(y[0], y[1]); o0.y = pk2(y[2], y[3]); o0.z = pk2(y[4], y[5]); o0.w = pk2(y[6], y[7]); o1.x = pk2(y[8], y[9]); o1.y = pk2(y[10], y[11]); o1.z = pk2(y[12], y[13]); o1.w = pk2(y[14], y[15]);
              LAS bf16* dst = (ty == 0 ? Qs : Ks) + t * RP + cg * 16; *(LAS u32x4*)dst = o0; *(LAS u32x4*)(dst + 8) = o1; }
          if (ty >= 1) { const float sc = ty == 1 ? bet : btt; LAS bf16* rt = RT + ((ty == 1 ? 128 : 0) + cg * 16) * RTP + t;
#pragma unroll
              for (int e = 0; e < 16; ++e) rt[e * RTP] = (bf16)f2bf(y[e] * sc); } } }
    __syncthreads();
    { unsigned z0 = 0u; asm volatile("" : "+v"(z0)); ((LAS u32x4*)Tb)[C.tid] = (u32x4){z0, z0, z0, z0}; if (C.tid < 64) ((LAS u32x4*)Tb)[512 + C.tid] = (u32x4){z0, z0, z0, z0}; }
    for (int job = C.wave; job < 26; job += 8) { const int ty = job >= 10; int mt, nt;
        if (ty) { mt = (job - 10) >> 2; nt = (job - 10) & 3; } else { mt = job < 1 ? 0 : job < 3 ? 1 : job < 6 ? 2 : 3; nt = job - (mt * (mt + 1)) / 2; }
        const f32x4 ct4 = *(const LAS f32x4*)(cs + 16 * mt + 4 * g), bt4 = *(const LAS f32x4*)(bt + 16 * mt + 4 * g); const float csx = cs[16 * nt + rr];
        f32x4 acc = (f32x4){0.f, 0.f, 0.f, 0.f};
        if (nt <= mt) acc = score_tile(ty ? Qs : Ks, Ks, mt, nt, C.lane);
#pragma unroll
        for (int r = 0; r < 4; ++r) { const int t = 16 * mt + 4 * g + r, sx = 16 * nt + rr; const float dec = __expf(fminf(ct4[r] - csx, 0.f));
            if (ty) *(LAS bf16*)(L + O_QK + img_off(t, sx, 2)) = (bf16)f2bf(sx <= t ? acc[r] * dec : 0.f);
            else Am[t * 64 + sx] = sx < t ? bt4[r] * acc[r] * dec : 0.f; } }
    { const int t = C.tid >> 3, cg = C.tid & 7; const float e_t = ec[t];
      const u32x4 q0 = *(const LAS u32x4*)(Qs + t * RP + cg * 16), q1 = *(const LAS u32x4*)(Qs + t * RP + cg * 16 + 8); const unsigned qw[8] = {q0.x, q0.y, q0.z, q0.w, q1.x, q1.y, q1.z, q1.w};
#pragma unroll
      for (int i = 0; i < 4; ++i) { u32x2 w2; w2.x = pk2(bflo(qw[2 * i]) * e_t, bfhi(qw[2 * i]) * e_t); w2.y = pk2(bflo(qw[2 * i + 1]) * e_t, bfhi(qw[2 * i + 1]) * e_t);
          *(LAS u32x2*)(L + ((t >> 4) * 4 + (cg >> 1)) * 1024 + (((t & 15) * 64 + 16 * i + 8 * (cg & 1)) ^ (((t & 15) >> 3) << 5))) = w2; } }
    { const int d = C.tid & 127, tg = C.tid >> 7; const float clast = cs[63]; float kv[16];
#pragma unroll
      for (int e = 0; e < 16; ++e) kv[e] = bf2f(Ks[(16 * tg + e) * RP + d]);
#pragma unroll
      for (int i = 0; i < 4; ++i) { const f32x4 c4 = *(const LAS f32x4*)(cs + 16 * tg + 4 * i); u32x2 w2;
          w2.x = pk2(kv[4 * i] * __expf(clast - c4[0]), kv[4 * i + 1] * __expf(clast - c4[1])); w2.y = pk2(kv[4 * i + 2] * __expf(clast - c4[2]), kv[4 * i + 3] * __expf(clast - c4[3]));
          *(LAS u32x2*)(L + O_KT + ((d >> 4) * 2 + (tg >> 1)) * 1024 + (((d & 15) * 64 + 16 * i + 8 * (tg & 1)) ^ (((d & 15) >> 3) << 5))) = w2; }
      if (C.tid < 256) *(LAS float*)(L + O_E + 4 * C.tid) = C.tid < 128 ? __expf(clast) : 0.f; }
    __syncthreads();
    if (C.wave == 0) {
        float t[16]; const LAS float* Ab = Am + (16 * g) * 64 + 16 * g;
        inv_rows4<0>(t, Ab, rr); inv_rows4<1>(t, Ab, rr); inv_rows4<2>(t, Ab, rr); inv_rows4<3>(t, Ab, rr);
        LDS_WAIT(); asm volatile("" ::: "memory");
#pragma unroll
        for (int r = 0; r < 16; ++r) { Am[(16 * g + r) * 64 + 16 * g + rr] = t[r]; Tb[(16 * g + r) * TBP + 16 * g + rr] = (bf16)f2bf(t[r]); }
        LDS_WAIT(); asm volatile("" ::: "memory");
#define AOP(I_, K_) pack4(*(const LAS f32x4*)(Am + (16 * (I_) + rr) * 64 + 16 * (K_) + 4 * g))
        bf16x4 Bd[3], Ta[4];
#pragma unroll
        for (int J = 0; J < 3; ++J) { f32x4 v;
#pragma unroll
            for (int j = 0; j < 4; ++j) v[j] = Am[(16 * J + 4 * g + j) * 64 + 16 * J + rr]; Bd[J] = pack4(v); }
#pragma unroll
        for (int I = 1; I < 4; ++I) Ta[I] = AOP(I, I);
        const f32x4 zero4 = (f32x4){0.f, 0.f, 0.f, 0.f};
        f32x4 T10, T21, T32, T20, T31, T30, M;
        M = mfma16k16(AOP(1, 0), Bd[0], zero4); T10 = zero4 - mfma16k16(Ta[1], pack4(M), zero4);
        M = mfma16k16(AOP(2, 1), Bd[1], zero4); T21 = zero4 - mfma16k16(Ta[2], pack4(M), zero4);
        M = mfma16k16(AOP(3, 2), Bd[2], zero4); T32 = zero4 - mfma16k16(Ta[3], pack4(M), zero4);
        M = mfma16k16(AOP(2, 0), Bd[0], zero4); M = mfma16k16(AOP(2, 1), pack4(T10), M); T20 = zero4 - mfma16k16(Ta[2], pack4(M), zero4);
        M = mfma16k16(AOP(3, 1), Bd[1], zero4); M = mfma16k16(AOP(3, 2), pack4(T21), M); T31 = zero4 - mfma16k16(Ta[3], pack4(M), zero4);
        M = mfma16k16(AOP(3, 0), Bd[0], zero4); M = mfma16k16(AOP(3, 1), pack4(T10), M); M = mfma16k16(AOP(3, 2), pack4(T20), M); T30 = zero4 - mfma16k16(Ta[3], pack4(M), zero4);
#undef AOP
#define TST(I_, J_, V_) do { _Pragma("unroll") for (int r = 0; r < 4; ++r) Tb[(16 * (I_) + 4 * g + r) * TBP + 16 * (J_) + rr] = (bf16)f2bf((V_)[r]); } while (0)
        TST(1, 0, T10); TST(2, 1, T21); TST(3, 2, T32); TST(2, 0, T20); TST(3, 1, T31); TST(3, 0, T30);
#undef TST
    }
    __syncthreads();
#pragma unroll
    for (int q = 0; q < 2; ++q) { const int nt = 2 * C.wave + q; f32x4 acc[4];
#pragma unroll
        for (int mt = 0; mt < 4; ++mt) acc[mt] = (f32x4){0.f, 0.f, 0.f, 0.f};
        bf16x8 bfr[2], afr[4][2];
#pragma unroll
        for (int kk = 0; kk < 2; ++kk) { bfr[kk] = *(const LAS bf16x8*)(RT + (16 * nt + rr) * RTP + 32 * kk + 8 * g);
#pragma unroll
            for (int mt = 0; mt < 4; ++mt) afr[mt][kk] = *(const LAS bf16x8*)(Tb + (16 * mt + rr) * TBP + 32 * kk + 8 * g); }
#pragma unroll
        for (int kk = 0; kk < 2; ++kk)
#pragma unroll
            for (int mt = 0; mt < 4; ++mt) acc[mt] = mfma16(afr[mt][kk], bfr[kk], acc[mt]);
        if (nt < 8) { u32x4 o0, o1; o0.x = pk2(acc[0][0], acc[0][1]); o0.y = pk2(acc[0][2], acc[0][3]); o0.z = pk2(acc[1][0], acc[1][1]); o0.w = pk2(acc[1][2], acc[1][3]);
            o1.x = pk2(acc[2][0], acc[2][1]); o1.y = pk2(acc[2][2], acc[2][3]); o1.z = pk2(acc[3][0], acc[3][1]); o1.w = pk2(acc[3][2], acc[3][3]);
            u32x4* up = (u32x4*)(rec + O_U + (nt * 64 + C.lane) * 32); up[0] = o0; up[1] = o1; }
        else {
#pragma unroll
            for (int mt = 0; mt < 4; ++mt)
#pragma unroll
                for (int r = 0; r < 4; ++r) *(LAS bf16*)(L + img_off(64 + 16 * mt + 4 * g + r, 16 * (nt - 8) + rr, 4)) = (bf16)f2bf(acc[mt][r]); } }
    __syncthreads();
    copy_record(C, rec, O_U);
    __syncthreads();
}

template <int MODE>
__device__ __forceinline__ void phase_r1(const Ctx& C, int l) {
    R1Pre P; int item = C.bid;
    if (item < 4096) r1_prefetch(C, l, item, P);
    for (; item < 4096; item += C.G) {
        const int gd = item < 2048, r = item & 2047, b = r >> 7, h = (r >> 5) & 3, n = r & 31;
        if (gd) r1_gdn(C, l, b, h, n, P, item + C.G); else r1_hgrn2(C, l, b, h, n, P, item + C.G);
    }
}

template <int GD>
__device__ __forceinline__ void r2_chain(const Ctx& C, int l, int b, int h) {
    KParams pp_ = C.p; const auto& p = *pp_; unsigned char* ws = C.ws; LAS unsigned char* L = C.lds;
    constexpr int BUFB = 58368; LAS float* OS = (LAS float*)(L + 2 * BUFB);
    asm volatile("" : "+v"(OS));
    const bf16* PROJ = (const bf16*)(ws + WS_PROJ1); bf16* Y = (bf16*)(ws + WS_Y);
    const int rr = C.lane & 15, g = C.lane >> 4, w = C.wave;
    const int aoffl = (rr * 64 + g * 16) ^ ((rr >> 3) << 5);
    constexpr int recsz = GD ? REC_G : REC_H, npc = GD ? 57 : 41, o_kt = GD ? 32768 : 16384, o_qk = GD ? 49152 : 32768, o_e = GD ? 57344 : 40960, o_u = GD ? 58368 : 41984, MQ = GD ? 8 : 4;
    const unsigned char* rec0 = GD ? ws + WS_RECG + (size_t)(b * 4 + h) * 32 * REC_G : rech_ptr(ws, b, h, 0);
    const float nw0 = p.in[GD ? I_GDNW : I_HGNW][l * 128 + 2 * C.lane], nw1 = p.in[GD ? I_GDNW : I_HGNW][l * 128 + 2 * C.lane + 1];
    f32x4 S[8];
#pragma unroll
    for (int i = 0; i < 8; ++i) S[i] = (f32x4){0.f, 0.f, 0.f, 0.f};
    __syncthreads();
    u32x4 un0 = *(const u32x4*)(rec0 + o_u + (w * 64 + C.lane) * 32), un1 = *(const u32x4*)(rec0 + o_u + (w * 64 + C.lane) * 32 + 16);
    for (int pc = w; pc < npc; pc += 8) __builtin_amdgcn_global_load_lds((const unsigned*)(rec0 + pc * 1024 + C.lane * 16), (LAS unsigned*)(L + pc * 1024), 16, 0, 0);
    for (int n = 0; n < 32; ++n) {
        LAS unsigned char* B = L + (n & 1) * BUFB; const size_t tok0 = (size_t)b * T + n * 64;
        const u32x4 uc0 = un0, uc1 = un1;
        VM_WAIT(); __builtin_amdgcn_s_barrier(); asm volatile("" ::: "memory");
        unsigned zg[8];
#pragma unroll
        for (int i = 0; i < 8; ++i) zg[i] = *(const unsigned*)(PROJ + (tok0 + 8 * w + i) * P1W + (GD ? C_GZ : C_HZ) + h * 128 + 2 * C.lane);
        if (n + 1 < 32) { const unsigned char* rn = rec0 + (size_t)(n + 1) * recsz;
            un0 = *(const u32x4*)(rn + o_u + (w * 64 + C.lane) * 32); un1 = *(const u32x4*)(rn + o_u + (w * 64 + C.lane) * 32 + 16);
            LAS unsigned char* Bn = L + ((n + 1) & 1) * BUFB;
            for (int pc = w; pc < npc; pc += 8) __builtin_amdgcn_global_load_lds((const unsigned*)(rn + pc * 1024 + C.lane * 16), (LAS unsigned*)(Bn + pc * 1024), 16, 0, 0); }
#define R2_LD(dst, base, cnt) do { _Pragma("unroll") for (int q_ = 0; q_ < (cnt); ++q_) dst[q_] = *(const LAS bf16x8*)((base) + q_ * 1024 + aoffl); } while (0)
        const LAS unsigned char* Bq = B; const LAS unsigned char* Bqk = B + o_qk; const LAS unsigned char* Bkt = B + o_kt;
        bf16x8 sf[4];
#pragma unroll
        for (int kk = 0; kk < 4; ++kk) { u32x4 t4; t4.x = pk2(S[2 * kk][0], S[2 * kk][1]); t4.y = pk2(S[2 * kk][2], S[2 * kk][3]); t4.z = pk2(S[2 * kk + 1][0], S[2 * kk + 1][1]); t4.w = pk2(S[2 * kk + 1][2], S[2 * kk + 1][3]); sf[kk] = __builtin_bit_cast(bf16x8, t4); }
        f32x4 P[8];
#pragma unroll
        for (int m = 0; m < 8; ++m) P[m] = (f32x4){0.f, 0.f, 0.f, 0.f};
        bf16x8 fa[8], fb[8];
#pragma unroll
        for (int m = 0; m < MQ; ++m) fa[m] = *(const LAS bf16x8*)(Bq + (m * 4 + 0) * 1024 + aoffl);
        __builtin_amdgcn_sched_barrier(0);
#pragma unroll
        for (int m = 0; m < MQ; ++m) fb[m] = *(const LAS bf16x8*)(Bq + (m * 4 + 1) * 1024 + aoffl);
#pragma unroll
        for (int m = 0; m < MQ; ++m) P[m] = mfma16(fa[m], sf[0], P[m]);
        __builtin_amdgcn_sched_barrier(0);
#pragma unroll
        for (int m = 0; m < MQ; ++m) fa[m] = *(const LAS bf16x8*)(Bq + (m * 4 + 2) * 1024 + aoffl);
#pragma unroll
        for (int m = 0; m < MQ; ++m) P[m] = mfma16(fb[m], sf[1], P[m]);
        __builtin_amdgcn_sched_barrier(0);
#pragma unroll
        for (int m = 0; m < MQ; ++m) fb[m] = *(const LAS bf16x8*)(Bq + (m * 4 + 3) * 1024 + aoffl);
#pragma unroll
        for (int m = 0; m < MQ; ++m) P[m] = mfma16(fa[m], sf[2], P[m]);
        __builtin_amdgcn_sched_barrier(0);
        R2_LD(fa, Bqk, 8);
#pragma unroll
        for (int m = 0; m < MQ; ++m) P[m] = mfma16(fb[m], sf[3], P[m]);
        __builtin_amdgcn_sched_barrier(0);
        f32x4 vn[4];
        { const unsigned uu[8] = {uc0.x, uc0.y, uc0.z, uc0.w, uc1.x, uc1.y, uc1.z, uc1.w};
#pragma unroll
          for (int m = 0; m < 4; ++m) { vn[m] = (f32x4){bflo(uu[2 * m]), bfhi(uu[2 * m]), bflo(uu[2 * m + 1]), bfhi(uu[2 * m + 1])}; if (GD) vn[m] = vn[m] - P[4 + m]; } }
        bf16x8 vf[2];
#pragma unroll
        for (int kk = 0; kk < 2; ++kk) { u32x4 t4; t4.x = pk2(vn[2 * kk][0], vn[2 * kk][1]); t4.y = pk2(vn[2 * kk][2], vn[2 * kk][3]); t4.z = pk2(vn[2 * kk + 1][0], vn[2 * kk + 1][1]); t4.w = pk2(vn[2 * kk + 1][2], vn[2 * kk + 1][3]); vf[kk] = __builtin_bit_cast(bf16x8, t4); }
        R2_LD(fb, Bkt, 8);
        f32x4 ev[8];
#pragma unroll
        for (int i = 0; i < 8; ++i) ev[i] = *(const LAS f32x4*)(B + o_e + (16 * i + 4 * g) * 4);
#pragma unroll
        for (int kk = 0; kk < 2; ++kk)
#pragma unroll
            for (int m = 0; m < 4; ++m) P[m] = mfma16(fa[2 * m + kk], vf[kk], P[m]);
        __builtin_amdgcn_sched_barrier(0);
        R2_LD(fa, Bkt + 8 * 1024, 8);
#pragma unroll
        for (int i = 0; i < 4; ++i) S[i] = S[i] * ev[i];
#pragma unroll
        for (int kk = 0; kk < 2; ++kk)
#pragma unroll
            for (int i = 0; i < 4; ++i) S[i] = mfma16(fb[2 * i + kk], vf[kk], S[i]);
        __builtin_amdgcn_sched_barrier(0);
#pragma unroll
        for (int i = 4; i < 8; ++i) S[i] = S[i] * ev[i];
#pragma unroll
        for (int kk = 0; kk < 2; ++kk)
#pragma unroll
            for (int i = 0; i < 4; ++i) S[4 + i] = mfma16(fa[2 * i + kk], vf[kk], S[4 + i]);
#undef R2_LD
#pragma unroll
        for (int m = 0; m < 4; ++m)
#pragma unroll
            for (int r = 0; r < 4; ++r) OS[(16 * m + 4 * g + r) * 132 + 16 * w + rr] = P[m][r];
        LDS_WAIT(); __builtin_amdgcn_s_barrier(); asm volatile("" ::: "memory");
        f32x2 o2[8]; float ssq[8];
#pragma unroll
        for (int i = 0; i < 8; ++i) { o2[i] = *(const LAS f32x2*)(OS + (8 * w + i) * 132 + 2 * C.lane); ssq[i] = row16_sum(o2[i].x * o2[i].x + o2[i].y * o2[i].y); }
#pragma unroll
        for (int i = 0; i < 8; ++i) ssq[i] += shx(ssq[i], 16, C.lane);
#pragma unroll
        for (int i = 0; i < 8; ++i) ssq[i] += shx(ssq[i], 32, C.lane);
#pragma unroll
        for (int i = 0; i < 8; ++i) { const int t = 8 * w + i; const float r = __builtin_amdgcn_rsqf(ssq[i] * (1.f / 128.f) + RMS_EPS);
            const float z0 = bflo(zg[i]), z1 = bfhi(zg[i]); const float g0 = GD ? z0 * sigmoidf_(z0) : sigmoidf_(z0), g1 = GD ? z1 * sigmoidf_(z1) : sigmoidf_(z1);
            *(unsigned*)(Y + (tok0 + t) * D + GD * 512 + h * 128 + 2 * C.lane) = pk2(o2[i].x * r * nw0 * g0, o2[i].y * r * nw1 * g1); }
    }
    VM_WAIT(); __syncthreads();
}
template <int MODE>
__device__ __forceinline__ void phase_r2(const Ctx& C, int l) {
    for (int item = C.bid; item < NB * 8; item += C.G) {
        const int b = item >> 3, h8 = item & 7, gd = h8 >> 2, h = h8 & 3;
        if (gd) r2_chain<1>(C, l, b, h); else r2_chain<0>(C, l, b, h);
    }
}

template <int MODE, int GB>
__device__ __forceinline__ void phase_ln(const Ctx& C, int l, int which, bool last) {
    KParams pp_ = C.p; const auto& p = *pp_; unsigned char* ws = C.ws;
    const f32x4* gp = (const f32x4*)(p.in[I_LNG] + ((size_t)l * 3 + which) * D); const f32x4* bp = (const f32x4*)(p.in[I_LNB] + ((size_t)l * 3 + which) * D);
    f32x4 g[4], bb[4];
#pragma unroll
    for (int j = 0; j < 4; ++j) { g[j] = gp[C.lane + 64 * j]; bb[j] = bp[C.lane + 64 * j]; }
    LAS float* wl = (LAS float*)C.lds;
    if (GB && !last) { stage_wab(C, wl, l + 1); __syncthreads(); }
    for (int m0 = C.gw; m0 < NTOK; m0 += 2 * C.ngw) {
        f32x4 v[2][4]; f32x4* xr[2];
#pragma unroll
        for (int q = 0; q < 2; ++q) { const int m = m0 + q * C.ngw;
            xr[q] = (f32x4*)((float*)(ws + WS_X) + (size_t)m * D) + C.lane;
            const u32x2* f0; const u32x2* f1 = nullptr; float w0 = 1.f, w1 = 0.f;
            if (MODE == 0) f0 = (const u32x2*)((const bf16*)(ws + WS_F) + (size_t)m * D) + C.lane;
            else { const int d0 = ((const int*)(ws + WS_G + G_DEST))[2 * m], d1 = ((const int*)(ws + WS_G + G_DEST))[2 * m + 1]; w0 = ((const float*)(ws + WS_G + G_GATES))[2 * m]; w1 = ((const float*)(ws + WS_G + G_GATES))[2 * m + 1];
                f0 = (const u32x2*)((const bf16*)(ws + WS_BUF) + (size_t)d0 * D) + C.lane; f1 = (const u32x2*)((const bf16*)(ws + WS_BUF) + (size_t)d1 * D) + C.lane; }
#pragma unroll
            for (int j = 0; j < 4; ++j) { const f32x4 x = xr[q][64 * j]; const u32x2 a = f0[64 * j]; f32x4 f = (f32x4){bflo(a.x), bfhi(a.x), bflo(a.y), bfhi(a.y)};
                if (MODE == 1) { const u32x2 c = f1[64 * j]; f = f * w0 + (f32x4){bflo(c.x), bfhi(c.x), bflo(c.y), bfhi(c.y)} * w1; }
                v[q][j] = x * ALPHA + f; } }
#pragma unroll
        for (int q = 0; q < 2; ++q) { const int m = m0 + q * C.ngw; float s = 0.f;
#pragma unroll
            for (int j = 0; j < 4; ++j) s += (v[q][j][0] + v[q][j][1]) + (v[q][j][2] + v[q][j][3]);
            const float mean = wave_sum(s, C.lane) * (1.f / D); float s2 = 0.f;
#pragma unroll
            for (int j = 0; j < 4; ++j) { v[q][j] = v[q][j] - mean; s2 += (v[q][j][0] * v[q][j][0] + v[q][j][1] * v[q][j][1]) + (v[q][j][2] * v[q][j][2] + v[q][j][3] * v[q][j][3]); }
            const float rstd = __builtin_amdgcn_rsqf(wave_sum(s2, C.lane) * (1.f / D) + LN_EPS);
            u32x2* xb = (u32x2*)((bf16*)(ws + WS_XN) + (size_t)m * D) + C.lane; f32x4* xo = (f32x4*)(p.out + (size_t)m * D) + C.lane;
#pragma unroll
            for (int j = 0; j < 4; ++j) { const f32x4 y = v[q][j] * rstd * g[j] + bb[j]; v[q][j] = y; xr[q][64 * j] = y; u32x2 w; w.x = pk2(y[0], y[1]); w.y = pk2(y[2], y[3]); xb[64 * j] = w; if (last) xo[64 * j] = y; }
            if (GB && !last) gb_row(C, v[q], wl, l + 1, (size_t)m); }
    }
    if (GB) __syncthreads();
}

__device__ __forceinline__ void phase_route(const Ctx& C, int l) {
    KParams pp_ = C.p; const auto& p = *pp_; unsigned char* ws = C.ws;
    LAS float* xs = (LAS float*)C.lds;
    LAS float* wsh = xs + 128 * 65;
    LAS float* lg = wsh + 64 * 36;
    LAS int* es = (LAS int*)(lg + 128 * 36);
    LAS int* rk = es + 256;
    const float* X = (const float*)(ws + WS_X);
    const float* wg = p.in[I_WGRP] + (size_t)l * D * 4; const float* wr_ = p.in[I_WRT] + (size_t)l * D * 32;
    const int t = C.tid & 127, og = C.tid >> 7;
    for (int item = C.bid; item < 256; item += C.G) {
        const size_t tok0 = (size_t)item * 128;
        float acc[9];
#pragma unroll
        for (int i = 0; i < 9; ++i) acc[i] = 0.f;
        float xr_[16], wr5[5];
#pragma unroll
        for (int i = 0; i < 16; ++i) { const int idx = C.tid + 512 * i, r = idx >> 6, c = idx & 63; xr_[i] = X[(tok0 + r) * D + c]; }
#pragma unroll
        for (int i = 0; i < 5; ++i) { const int idx = C.tid + 512 * i; wr5[i] = 0.f; if (idx < 64 * 36) { const int k = idx / 36, o = idx % 36; wr5[i] = o < 4 ? wg[(size_t)k * 4 + o] : wr_[(size_t)k * 32 + o - 4]; } }
        for (int k0 = 0; k0 < D; k0 += 64) {
            __syncthreads();
#pragma unroll
            for (int i = 0; i < 16; ++i) { const int idx = C.tid + 512 * i, r = idx >> 6, c = idx & 63; xs[r * 65 + c] = xr_[i]; }
#pragma unroll
            for (int i = 0; i < 5; ++i) { const int idx = C.tid + 512 * i; if (idx < 64 * 36) wsh[idx] = wr5[i]; }
            __syncthreads();
            if (k0 + 64 < D) {
#pragma unroll
                for (int i = 0; i < 16; ++i) { const int idx = C.tid + 512 * i, r = idx >> 6, c = idx & 63; xr_[i] = X[(tok0 + r) * D + k0 + 64 + c]; }
#pragma unroll
                for (int i = 0; i < 5; ++i) { const int idx = C.tid + 512 * i; if (idx < 64 * 36) { const int k = idx / 36, o = idx % 36; wr5[i] = o < 4 ? wg[(size_t)(k0 + 64 + k) * 4 + o] : wr_[(size_t)(k0 + 64 + k) * 32 + o - 4]; } } }
#pragma unroll 8
            for (int k = 0; k < 64; ++k) { const float xv = xs[t * 65 + k];
#pragma unroll
                for (int i = 0; i < 9; ++i) acc[i] += xv * wsh[k * 36 + og * 9 + i]; }
        }
#pragma unroll
        for (int i = 0; i < 9; ++i) lg[t * 36 + og * 9 + i] = acc[i];
        __syncthreads();
        int e0 = 0, e1 = 0; float w0 = 0.f, w1 = 0.f;
        if (C.tid < 128) {
            float gl[4]; int gsel = 0;
#pragma unroll
            for (int j = 0; j < 4; ++j) gl[j] = lg[C.tid * 36 + j] + p.in[I_BGRP][l * 4 + j];
#pragma unroll
            for (int j = 1; j < 4; ++j) if (gl[j] > gl[gsel]) gsel = j;
            float gsum = 0.f;
#pragma unroll
            for (int j = 0; j < 4; ++j) gsum += expf(gl[j] - gl[gsel]);
            const float ggate = 1.0f / gsum;
            float el[8];
#pragma unroll
            for (int j = 0; j < 8; ++j) el[j] = lg[C.tid * 36 + 4 + gsel * 8 + j] + p.in[I_BRT][l * 32 + gsel * 8 + j];
            int t1 = 0;
#pragma unroll
            for (int j = 1; j < 8; ++j) if (el[j] > el[t1]) t1 = j;
            int t2 = (t1 == 0) ? 1 : 0;
#pragma unroll
            for (int j = 0; j < 8; ++j) if (j != t1 && el[j] > el[t2]) t2 = j;
            const float ex = expf(el[t2] - el[t1]); w0 = ggate / (1.f + ex); w1 = ggate * ex / (1.f + ex);
            e0 = gsel * 8 + t1; e1 = gsel * 8 + t2; es[2 * C.tid] = e0; es[2 * C.tid + 1] = e1;
        }
        __syncthreads();
        if (C.tid < 32) { int cnt = 0; for (int a = 0; a < 256; ++a) if (es[a] == C.tid) { rk[a] = cnt; ++cnt; } ((int*)(ws + WS_SMALL + SM_CNT))[item * 32 + C.tid] = cnt; }
        __syncthreads();
        if (C.tid < 128) { const size_t tok = tok0 + C.tid; int* ro = (int*)(ws + WS_G + G_ROUTE) + tok * 4; ro[0] = e0; ro[1] = e1; ro[2] = rk[2 * C.tid]; ro[3] = rk[2 * C.tid + 1];
            float* gt = (float*)(ws + WS_G + G_GATES) + tok * 2; gt[0] = w0; gt[1] = w1; }
    }
    __syncthreads();
}

__device__ __forceinline__ void phase_dispatch(const Ctx& C) {
    unsigned char* ws = C.ws;
    LAS int* cn = (LAS int*)C.lds;
    LAS int* tot = cn + 8192; LAS int* bef = tot + 32; LAS int* base = bef + 32; LAS int* pst = base + 32; LAS int* dl = pst + 32;
    const int* cnt_all = (const int*)(ws + WS_SMALL + SM_CNT);
    bf16* BUF = (bf16*)(ws + WS_BUF); const bf16* XN = (const bf16*)(ws + WS_XN);
    for (int item = C.bid; item < 256; item += C.G) {
        __syncthreads();
        for (int i = C.tid; i < 8192; i += 512) cn[i] = cnt_all[i];
        __syncthreads();
        if (C.tid < 32) { int s = 0, bsum = 0; for (int b = 0; b < 256; ++b) { const int c = cn[b * 32 + C.tid]; if (b < item) bsum += c; s += c; } tot[C.tid] = s; bef[C.tid] = bsum; }
        __syncthreads();
        if (C.tid == 0) { int ps = 0; for (int e = 0; e < 32; ++e) { pst[e] = ps; base[e] = ps + bef[e]; ps += (tot[e] + 255) & ~255; }
            if (item == 0) { int* tt = (int*)(ws + WS_SMALL + SM_TILE); tt[0] = ps >> 8; for (int e = 0; e < 32; ++e) for (int r = pst[e]; r < pst[e] + ((tot[e] + 255) & ~255); r += 256) tt[16 + (r >> 8)] = e; } }
        __syncthreads();
        if (C.tid < 128) { const size_t tok = (size_t)item * 128 + C.tid; const int* ro = (const int*)(ws + WS_G + G_ROUTE) + tok * 4; const int d0 = base[ro[0]] + ro[2], d1 = base[ro[1]] + ro[3];
            int* dd = (int*)(ws + WS_G + G_DEST) + tok * 2; dd[0] = d0; dd[1] = d1; dl[2 * C.tid] = d0; dl[2 * C.tid + 1] = d1; }
        __syncthreads();
        for (int a0 = C.wave * 32; a0 < C.wave * 32 + 32; a0 += 8) { u32x4 t0[8], t1[8];
#pragma unroll
            for (int q = 0; q < 8; ++q) { const size_t tok = (size_t)item * 128 + ((a0 + q) >> 1); const u32x4* src = (const u32x4*)(XN + tok * D); t0[q] = src[C.lane]; t1[q] = src[C.lane + 64]; }
#pragma unroll
            for (int q = 0; q < 8; ++q) { u32x4* dst = (u32x4*)(BUF + (size_t)dl[a0 + q] * D); dst[C.lane] = t0[q]; dst[C.lane + 64] = t1[q]; } }
        if (item < 32) { const int e = item, r0 = pst[e] + tot[e], r1 = pst[e] + ((tot[e] + 255) & ~255);
            for (int r = r0 + C.wave; r < r1; r += 8) { u32x4* dst = (u32x4*)(BUF + (size_t)r * D); dst[C.lane] = (u32x4){0u, 0u, 0u, 0u}; dst[C.lane + 64] = (u32x4){0u, 0u, 0u, 0u}; } }
    }
    __syncthreads();
}

__global__ void __launch_bounds__(512, 2) trunk_fwd(Params prm) {
    extern __shared__ __attribute__((aligned(16))) unsigned char lds_raw[];
#define MKCTX() Ctx C; { int t_ = wave0 * 64 + fresh_lane(); KParams kp_ = (KParams)__builtin_amdgcn_kernarg_segment_ptr(); asm volatile("" : "+s"(kp_)); unsigned char* w_ = kp_->ws; C.lds = (LAS unsigned char*)lds_raw; C.ws = w_; C.p = kp_; \
    C.tid = t_; C.lane = t_ & 63; C.wave = __builtin_amdgcn_readfirstlane(t_ >> 6); C.G = gridDim.x; C.bid = blockIdx.x; C.gw = C.bid * 8 + C.wave; C.ngw = C.G * 8; } \
    unsigned char* ws = C.ws; LAS unsigned char* ring = C.lds; (void)ws; (void)ring
    const int tid0 = threadIdx.x; const int wave0 = __builtin_amdgcn_readfirstlane(tid0 >> 6);
    volatile LAS unsigned* MISC = (volatile LAS unsigned*)((LAS unsigned char*)lds_raw + MISC_OFF);
    if (tid0 < 32) MISC[tid0] = 0u;
    __syncthreads();
    const int lo = prm.ph_lo, hi = prm.ph_hi;
    unsigned* barw = (unsigned*)(prm.ws + WS_CTL) + 4096;
    XcdBarrier bar; bar.bar = barw; bar.x = 0; bar.st = MISC + 8;
    if (hi - lo > 1) bar = xcd_barrier_post(barw, MISC + 8, tid0);
#ifndef ENMASK
#define ENMASK 0xFFFFFFu
#endif
#define EN(j) (((ENMASK) >> (j)) & 1u)
#ifndef DUPMASK
#define DUPMASK 0u
#endif
#define REPS(j) int nrep_ = 1 + (int)(((DUPMASK) >> (j)) & 1u); if ((DUPMASK) != 0u) asm volatile("" : "+s"(nrep_)); for (int rep_ = 0; rep_ < nrep_; ++rep_)
#define IN(k) (lo <= (k) && (k) < hi)
#define SEAM(k) do { if (IN(k) && IN((k) + 1)) xcd_barrier(bar, wave0 * 64 + fresh_lane()); } while (0)

    if (EN(0) && IN(PH_PRO)) { REPS(0) { MKCTX(); phase_prologue(C); } } SEAM(PH_PRO);
    if (EN(1) && IN(PH_KV)) { REPS(1) { MKCTX();
        pg8::Shape g{D, D, D}; SchedKV S{(const char*)(size_t)(WS_MEMN), (const char*)(size_t)(WS_W_K), (const char*)(size_t)(WS_W_V), C.G, C.bid};
        pg8::EpiBf16 E{(bf16*)(ws + WS_KMEM), (bf16*)(ws + WS_VT), 4096, 1.0f};
        pg8::gemm_phase<pg8::EpiBf16, SchedKV>(ring, g, S, E, C.tid, ws);
    } } SEAM(PH_KV);

    for (int l = 0; l < DEPTH; ++l) {
        const int pb = PH_L0 + l * PH_PER_LAYER;
        if (EN(2) && IN(pb + 0)) { REPS(2) { MKCTX();
            pg8::Shape g{D, D, D}; SchedDense S{(const char*)(size_t)(WS_XN), (const char*)(size_t)(WS_W_IN) + (size_t)l * PW * D * 2, NTOK / 256, PW / 256, D, D, C.G, C.bid};
            pg8::EpiProj E{(bf16*)(ws + WS_PROJ1), (bf16*)(ws + WS_PROJ2)};
            pg8::gemm_phase<pg8::EpiProj, SchedDense>(ring, g, S, E, C.tid, ws);
        } } SEAM(pb + 0);
        if (EN(4) && IN(pb + 2)) { REPS(4) { MKCTX(); phase_r1<2>(C, l); } } SEAM(pb + 2);
        if (EN(17) && IN(pb + 3)) { REPS(17) { MKCTX();
            if (C.G >= 256) { if (C.bid < 128) { C.G = 128; phase_r2<2>(C, l); } else { C.gw = (C.bid - 128) * 8 + C.wave; C.ngw = (C.G - 128) * 8; convert_experts(C, l); } }
            else { phase_r2<2>(C, l); convert_experts(C, l); } } } SEAM(pb + 3);
        if (EN(5) && IN(pb + 4)) { REPS(5) { MKCTX();
            pg8::Shape g{D, D, D}; SchedDense S{(const char*)(size_t)(WS_Y), (const char*)(size_t)(WS_W_OUT) + (size_t)l * D * D * 2, NTOK / 256, 4, D, D, C.G, C.bid};
            pg8::EpiBf16 E{(bf16*)(ws + WS_F), (bf16*)(ws + WS_F), D, 1.0f};
            pg8::gemm_phase<pg8::EpiBf16, SchedDense>(ring, g, S, E, C.tid, ws);
        } } SEAM(pb + 4);
        if (EN(6) && IN(pb + 5)) { REPS(6) { MKCTX(); phase_ln<0, 0>(C, l, 0, false); } } SEAM(pb + 5);
        if (EN(7) && IN(pb + 6)) { REPS(7) { MKCTX();
            pg8::Shape g{D, D, D}; SchedDense S{(const char*)(size_t)(WS_XN), (const char*)(size_t)(WS_W_Q) + (size_t)l * D * D * 2, NTOK / 256, 4, D, D, C.G, C.bid};
            pg8::EpiBf16 E{(bf16*)(ws + WS_Q), (bf16*)(ws + WS_Q), D, 0.0625f};
            pg8::gemm_phase<pg8::EpiBf16, SchedDense>(ring, g, S, E, C.tid, ws);
        } } SEAM(pb + 6);
        if (EN(8) && IN(pb + 7)) { REPS(8) { MKCTX();
            pg8::Shape g{256, D, 4096}; SchedAttn S{(const char*)(size_t)(WS_Q), (const char*)(size_t)(WS_KMEM), 0, l, C.G, C.bid};
            pg8::EpiSoftmax E{(bf16*)(ws + WS_P)};
            pg8::gemm_phase<pg8::EpiSoftmax, SchedAttn>(ring, g, S, E, C.tid, ws);
        } } SEAM(pb + 7);
        if (EN(9) && IN(pb + 8)) { REPS(9) { MKCTX();
            pg8::Shape g{256, D, 4096}; SchedAttnPV S{(const char*)(size_t)(WS_P), (const char*)(size_t)(WS_VT), l, C.G, C.bid};
            pg8::EpiBf16 E{(bf16*)(ws + WS_Y), (bf16*)(ws + WS_Y), D, 1.0f};
            pg8::gemm_phase<pg8::EpiBf16, SchedAttnPV>(ring, g, S, E, C.tid, ws);
        } } SEAM(pb + 8);
        if (EN(10) && IN(pb + 9)) { REPS(10) { MKCTX();
            pg8::Shape g{D, D, D}; SchedDense S{(const char*)(size_t)(WS_Y), (const char*)(size_t)(WS_W_O) + (size_t)l * D * D * 2, NTOK / 256, 4, D, D, C.G, C.bid};
            pg8::EpiBf16 E{(bf16*)(ws + WS_F), (bf16*)(ws + WS_F), D, 1.0f};
            pg8::gemm_phase<pg8::EpiBf16, SchedDense>(ring, g, S, E, C.tid, ws);
        } } SEAM(pb + 9);
        if (EN(11) && IN(pb + 10)) { REPS(11) { MKCTX(); phase_ln<0, 0>(C, l, 1, false); } } SEAM(pb + 10);
        if (EN(12) && IN(pb + 11)) { REPS(12) { MKCTX(); phase_route(C, l); } } SEAM(pb + 11);
        if (EN(13) && IN(pb + 12)) { REPS(13) { MKCTX(); phase_dispatch(C); } } SEAM(pb + 12);
        if (EN(14) && IN(pb + 13)) { REPS(14) { MKCTX();
            const int* tt = (const int*)(ws + WS_SMALL + SM_TILE); const int ntiles = __builtin_amdgcn_readfirstlane(tt[0]);
            pg8::Shape g{D, D, D}; SchedMoE S{(const char*)(size_t)(WS_BUF), (const char*)(size_t)(WS_GU), tt, ntiles, D, D, C.G, C.bid};
            pg8::EpiSwiGLU E{(bf16*)(ws + WS_H)};
            pg8::gemm_phase<pg8::EpiSwiGLU, SchedMoE>(ring, g, S, E, C.tid, ws);
        } } SEAM(pb + 13);
        if (EN(15) && IN(pb + 14)) { REPS(15) { MKCTX();
            const int* tt = (const int*)(ws + WS_SMALL + SM_TILE); const int ntiles = __builtin_amdgcn_readfirstlane(tt[0]);
            pg8::Shape g{DEXP, DEXP, DEXP}; SchedMoE S{(const char*)(size_t)(WS_H), (const char*)(size_t)(WS_DN), tt, ntiles, DEXP, DEXP, C.G, C.bid};
            pg8::EpiBf16 E{(bf16*)(ws + WS_BUF), (bf16*)(ws + WS_BUF), D, 1.0f};
            pg8::gemm_phase<pg8::EpiBf16, SchedMoE>(ring, g, S, E, C.tid, ws);
        } } SEAM(pb + 14);
        if (EN(16) && IN(pb + 15)) { REPS(16) { MKCTX(); phase_ln<1, 1>(C, l, 2, l == DEPTH - 1); } } SEAM(pb + 15);
    }
#undef IN
#undef SEAM
}

extern "C" void kernel_launch(void* const* d_in, const int* in_sizes, int n_in, void* d_out, int out_size, void* d_ws, size_t ws_size, hipStream_t stream) {
    static int grid = 0;
    if (grid == 0) {
        if (n_in != 25 || out_size != NTOK * D || ws_size < WS_END) { fprintf(stderr, "kernel_launch: unexpected sizes n_in %d out %d ws %zu (need %zu)\n", n_in, out_size, ws_size, (size_t)WS_END); grid = -1; return; }
        int dev = 0, cus = 0, per_cu = 0;
        if (hipGetDevice(&dev) != hipSuccess || hipDeviceGetAttribute(&cus, hipDeviceAttributeMultiprocessorCount, dev) != hipSuccess) { grid = -1; return; }
        if (hipFuncSetAttribute((const void*)trunk_fwd, hipFuncAttributeMaxDynamicSharedMemorySize, LDS_BYTES) != hipSuccess) { fprintf(stderr, "kernel_launch: hipFuncSetAttribute failed\n"); grid = -1; return; }
        if (hipOccupancyMaxActiveBlocksPerMultiprocessor(&per_cu, (const void*)trunk_fwd, 512, LDS_BYTES) != hipSuccess || per_cu < 1) fprintf(stderr, "kernel_launch: occupancy query reports %d\n", per_cu);
        (void)hipGetLastError();
        grid = cus;
    }
    if (grid < 0) return;
    (void)hipMemsetAsync((char*)d_ws + WS_CTL, 0, CTL_ZERO_BYTES, stream);
    Params a{};
    for (int i = 0; i < 25; ++i) a.in[i] = (const float*)d_in[i];
    a.out = (float*)d_out; a.ws = (unsigned char*)d_ws;
#if MK_ONE_LAUNCH
    a.ph_lo = 0; a.ph_hi = N_PHASES;
    hipLaunchKernelGGL(trunk_fwd, dim3(grid), dim3(512), LDS_BYTES, stream, a);
#else
    for (int ph = 0; ph < N_PHASES; ++ph) { a.ph_lo = ph; a.ph_hi = ph + 1; hipLaunchKernelGGL(trunk_fwd, dim3(grid), dim3(512), LDS_BYTES, stream, a); }
#endif
}
```
